# Optimizing an MI355X kernel written in HIP

```python
import jax, jax.numpy as jnp
from jax import lax
import numpy as np

D_MODEL = 4096
BATCH = 1
SEQ = 8192
DEPTH = 1
DEC_BATCH = 16
DEC_SEQ = 64
PAST_LEN = 1024

CHUNK = 64
EPS = 1e-6
MIX_DIM = D_MODEL
V_HEAD_DIM = 128
MLA_HEADS = (MIX_DIM // 2) // V_HEAD_DIM
QK_NOPE = 128
ROPE_DIM = 64
QK_DIM = QK_NOPE + ROPE_DIM
Q_LORA = 1024
KV_LORA = 512
ROPE_THETA = 10000.0
SOFTMAX_SCALE = QK_DIM ** -0.5
Q_BLOCK = 128
POOL_DIM = MIX_DIM - MLA_HEADS * V_HEAD_DIM
POOL_WINDOWS = (2, 4, 8, 16)
POOL_GROUPS = len(POOL_WINDOWS)
POOL_GC = POOL_DIM // POOL_GROUPS
POOL_HIST = max(POOL_WINDOWS) - 1
IN_DIM = Q_LORA + KV_LORA + ROPE_DIM + POOL_DIM
OFF_KV = Q_LORA
OFF_PE = Q_LORA + KV_LORA
OFF_POOL = Q_LORA + KV_LORA + ROPE_DIM
PEER_HEADS = 8
PEER_N_KEYS = 128
PEER_EXPERTS = PEER_N_KEYS * PEER_N_KEYS
PEER_KEY_DIM = 256
PEER_HALF = PEER_KEY_DIM // 2
PEER_TOPK = 16
PEER_BLOCK = 32

kernel_name = "hybrid_mla_pool_peer_stream_step"


def rmsnorm(x, g):
    xf = x.astype(jnp.float32)
    r = lax.rsqrt(jnp.mean(xf * xf, axis=-1, keepdims=True) + EPS)
    return (xf * r * g.astype(jnp.float32)).astype(x.dtype)


def rope(x, pos):
    half = ROPE_DIM // 2
    inv = ROPE_THETA ** (-2.0 * jnp.arange(half, dtype=jnp.float32) / ROPE_DIM)
    ang = pos.astype(jnp.float32)[:, None] * inv[None, :]
    shape = (1, pos.shape[0]) + (1,) * (x.ndim - 3) + (half,)
    cos = jnp.cos(ang).reshape(shape)
    sin = jnp.sin(ang).reshape(shape)
    xf = x.astype(jnp.float32)
    x1, x2 = xf[..., :half], xf[..., half:]
    return jnp.concatenate([x1 * cos - x2 * sin, x1 * sin + x2 * cos], axis=-1).astype(x.dtype)


def chunk_attn(q_nope, q_pe, k_nope, k_pe, v, q_pos, k_pos):
    s = (jnp.einsum('bqhd,bkhd->bhqk', q_nope, k_nope)
         + jnp.einsum('bqhr,bkr->bhqk', q_pe, k_pe)).astype(jnp.float32) * SOFTMAX_SCALE
    mask = (q_pos[:, None] // CHUNK) >= (k_pos[None, :] // CHUNK)
    s = jnp.where(mask[None, None], s, -jnp.inf)
    p = jax.nn.softmax(s, axis=-1)
    return jnp.einsum('bhqk,bkhd->bqhd', p.astype(v.dtype), v)


def mla_attention(q_nope, q_pe, k_nope, k_pe, v, q_pos, k_pos):
    B, T = q_nope.shape[0], q_nope.shape[1]
    if T > Q_BLOCK and T % Q_BLOCK == 0:
        nblk = T // Q_BLOCK
        qn = q_nope.reshape(B, nblk, Q_BLOCK, MLA_HEADS, QK_NOPE).transpose(1, 0, 2, 3, 4)
        qp = q_pe.reshape(B, nblk, Q_BLOCK, MLA_HEADS, ROPE_DIM).transpose(1, 0, 2, 3, 4)
        pb = q_pos.reshape(nblk, Q_BLOCK)
        o = lax.map(lambda a: chunk_attn(a[0], a[1], k_nope, k_pe, v, a[2], k_pos), (qn, qp, pb))
        o = o.transpose(1, 0, 2, 3, 4)
    else:
        o = chunk_attn(q_nope, q_pe, k_nope, k_pe, v, q_pos, k_pos)
    return o.reshape(B, T, MLA_HEADS * V_HEAD_DIM)


def pool_mixer(u_ext, abs_pos, T, pool_w, pool_scale):
    B, L, _ = u_ext.shape
    uf = u_ext.astype(jnp.float32)
    cs = jnp.cumsum(uf, axis=1)
    parts = []
    for g, w in enumerate(POOL_WINDOWS):
        c = cs[..., g * POOL_GC:(g + 1) * POOL_GC]
        lagged = jnp.pad(c, ((0, 0), (w, 0), (0, 0)))[:, :L]
        cnt = jnp.minimum(abs_pos + 1, w).astype(jnp.float32)[None, :, None]
        mean = (c - lagged) / cnt
        parts.append(mean[:, L - T:] - uf[:, L - T:, g * POOL_GC:(g + 1) * POOL_GC])
    d = jnp.stack(parts, axis=2)
    out = jnp.einsum('btgc,gce->btge', d, pool_w.astype(jnp.float32)).reshape(B, T, POOL_DIM)
    return (out * pool_scale.astype(jnp.float32)).astype(u_ext.dtype)


def peer_ffn(h, wq, sk1, sk2, u, v):
    B, T, D = h.shape
    q = jnp.einsum('btd,dhk->bthk', h, wq)
    s1 = jnp.einsum('bthk,hnk->bthn', q[..., :PEER_HALF], sk1).astype(jnp.float32)
    s2 = jnp.einsum('bthk,hnk->bthn', q[..., PEER_HALF:], sk2).astype(jnp.float32)
    v1, i1 = lax.top_k(s1, PEER_TOPK)
    v2, i2 = lax.top_k(s2, PEER_TOPK)
    nc = PEER_TOPK * PEER_TOPK
    cand = (v1[..., :, None] + v2[..., None, :]).reshape(B, T, PEER_HEADS, nc)
    cidx = (i1[..., :, None] * PEER_N_KEYS + i2[..., None, :]).reshape(B, T, PEER_HEADS, nc)
    top, sel = lax.top_k(cand, PEER_TOPK)
    idx = jnp.take_along_axis(cidx, sel, axis=-1)
    gate = jax.nn.softmax(top, axis=-1)
    n = B * T
    K = PEER_HEADS * PEER_TOPK
    nb = -(-n // PEER_BLOCK)
    pad = nb * PEER_BLOCK - n
    hf = jnp.pad(h.reshape(n, D), ((0, pad), (0, 0))).reshape(nb, PEER_BLOCK, D)
    idf = jnp.pad(idx.reshape(n, K), ((0, pad), (0, 0))).reshape(nb, PEER_BLOCK, K)
    gf = jnp.pad(gate.reshape(n, K), ((0, pad), (0, 0))).reshape(nb, PEER_BLOCK, K)

    def expert_block(args):
        hb, ib, gb = args
        a = jnp.einsum('nd,nkd->nk', hb, jnp.take(u, ib, axis=0)).astype(jnp.float32)
        act = (jax.nn.gelu(a, approximate=False) * gb).astype(hb.dtype)
        return jnp.einsum('nk,nkd->nd', act, jnp.take(v, ib, axis=0))

    y = lax.map(expert_block, (hf, idf, gf))
    return y.reshape(nb * PEER_BLOCK, D)[:n].reshape(B, T, D).astype(h.dtype)


def hybrid_layer(x, pos, ckv_hist, kpe_hist, pool_hist, ln1_g, w_in, q_norm_g, w_uq, kv_norm_g,
                 w_ukv, pool_w, pool_scale, w_o, ln2_g, peer_wq, peer_sk1, peer_sk2, peer_u, peer_v):
    B, T, _ = x.shape
    h = rmsnorm(x, ln1_g)
    z = jnp.einsum('btd,de->bte', h, w_in)
    zq, zkv = z[..., :OFF_KV], z[..., OFF_KV:OFF_PE]
    zpe, zpool = z[..., OFF_PE:OFF_POOL], z[..., OFF_POOL:]
    q = jnp.einsum('btc,che->bthe', rmsnorm(zq, q_norm_g), w_uq)
    q_nope, q_pe = q[..., :QK_NOPE], rope(q[..., QK_NOPE:], pos)
    ckv_new = rmsnorm(zkv, kv_norm_g)
    kpe_new = rope(zpe, pos)
    if ckv_hist is None:
        ckv_all, kpe_all, k_pos = ckv_new, kpe_new, pos
    else:
        ckv_all = jnp.concatenate([ckv_hist.astype(ckv_new.dtype), ckv_new], axis=1)
        kpe_all = jnp.concatenate([kpe_hist.astype(kpe_new.dtype), kpe_new], axis=1)
        k_pos = jnp.arange(ckv_all.shape[1], dtype=jnp.int32)
    kv = jnp.einsum('bsc,che->bshe', ckv_all, w_ukv)
    k_nope, v = kv[..., :QK_NOPE], kv[..., QK_NOPE:]
    o_mla = mla_attention(q_nope, q_pe, k_nope, kpe_all, v, pos, k_pos)
    if pool_hist is None:
        u_ext, abs_pos = zpool, pos
    else:
        u_ext = jnp.concatenate([pool_hist.astype(zpool.dtype), zpool], axis=1)
        abs_pos = pos[0] - POOL_HIST + jnp.arange(POOL_HIST + T, dtype=jnp.int32)
    o_pool = pool_mixer(u_ext, abs_pos, T, pool_w, pool_scale)
    pool_new = u_ext[:, -POOL_HIST:]
    o = jnp.concatenate([o_mla.astype(x.dtype), o_pool.astype(x.dtype)], axis=-1)
    x = x + jnp.einsum('btm,md->btd', o, w_o).astype(x.dtype)
    x = x + peer_ffn(rmsnorm(x, ln2_g), peer_wq, peer_sk1, peer_sk2, peer_u, peer_v)
    return x, ckv_new, kpe_new, pool_new


def setup_inputs(seed: int = 0) -> dict:
    key = jax.random.key(seed)
    ks = jax.random.split(key, 24)

    def nrm(k, shape, scale):
        return jax.random.normal(k, shape, jnp.float32) * scale

    return {
        "x_prompt": nrm(ks[0], (BATCH, SEQ, D_MODEL), 1.0),
        "x_sample": nrm(ks[1], (DEC_BATCH, DEC_SEQ, D_MODEL), 1.0),
        "cache_ckv": nrm(ks[2], (DEPTH, DEC_BATCH, PAST_LEN, KV_LORA), 1.0),
        "cache_kpe": nrm(ks[3], (DEPTH, DEC_BATCH, PAST_LEN, ROPE_DIM), 1.0),
        "state_pool": nrm(ks[4], (DEPTH, DEC_BATCH, POOL_HIST, POOL_DIM), 1.0),
        "ln1_g": 1.0 + nrm(ks[5], (DEPTH, D_MODEL), 0.02),
        "w_in": nrm(ks[6], (DEPTH, D_MODEL, IN_DIM), D_MODEL ** -0.5),
        "q_norm_g": 1.0 + nrm(ks[7], (DEPTH, Q_LORA), 0.02),
        "w_uq": nrm(ks[8], (DEPTH, Q_LORA, MLA_HEADS, QK_DIM), Q_LORA ** -0.5),
        "kv_norm_g": 1.0 + nrm(ks[9], (DEPTH, KV_LORA), 0.02),
        "w_ukv": nrm(ks[10], (DEPTH, KV_LORA, MLA_HEADS, QK_NOPE + V_HEAD_DIM), KV_LORA ** -0.5),
        "pool_w": nrm(ks[11], (DEPTH, POOL_GROUPS, POOL_GC, POOL_GC), POOL_GC ** -0.5),
        "pool_scale": 1.0 + nrm(ks[12], (DEPTH, POOL_DIM), 0.02),
        "w_o": nrm(ks[13], (DEPTH, MIX_DIM, D_MODEL), MIX_DIM ** -0.5),
        "ln2_g": 1.0 + nrm(ks[14], (DEPTH, D_MODEL), 0.02),
        "peer_wq": nrm(ks[15], (DEPTH, D_MODEL, PEER_HEADS, PEER_KEY_DIM), D_MODEL ** -0.5),
        "peer_sk1": nrm(ks[16], (DEPTH, PEER_HEADS, PEER_N_KEYS, PEER_HALF), PEER_HALF ** -0.5),
        "peer_sk2": nrm(ks[17], (DEPTH, PEER_HEADS, PEER_N_KEYS, PEER_HALF), PEER_HALF ** -0.5),
        "peer_u": nrm(ks[18], (DEPTH, PEER_EXPERTS, D_MODEL), D_MODEL ** -0.5),
        "peer_v": nrm(ks[19], (DEPTH, PEER_EXPERTS, D_MODEL), (PEER_HEADS * PEER_TOPK) ** -0.5),
        "final_g": 1.0 + nrm(ks[20], (D_MODEL,), 0.02),
    }


def reference(x_prompt, x_sample, cache_ckv, cache_kpe, state_pool, ln1_g, w_in, q_norm_g, w_uq,
              kv_norm_g, w_ukv, pool_w, pool_scale, w_o, ln2_g, peer_wq, peer_sk1, peer_sk2,
              peer_u, peer_v, final_g):
    xp, xs = x_prompt, x_sample
    past = cache_ckv.shape[2]
    pos_p = jnp.arange(xp.shape[1], dtype=jnp.int32)
    pos_s = past + jnp.arange(xs.shape[1], dtype=jnp.int32)
    ckv_p, kpe_p, pool_p, ckv_s, kpe_s, pool_s = [], [], [], [], [], []
    for l in range(DEPTH):
        w = (ln1_g[l], w_in[l], q_norm_g[l], w_uq[l], kv_norm_g[l], w_ukv[l], pool_w[l],
             pool_scale[l], w_o[l], ln2_g[l], peer_wq[l], peer_sk1[l], peer_sk2[l],
             peer_u[l], peer_v[l])
        xp, c1, k1, p1 = hybrid_layer(xp, pos_p, None, None, None, *w)
        xs, c2, k2, p2 = hybrid_layer(xs, pos_s, cache_ckv[l], cache_kpe[l], state_pool[l], *w)
        ckv_p.append(c1); kpe_p.append(k1); pool_p.append(p1)
        ckv_s.append(c2); kpe_s.append(k2); pool_s.append(p2)
    y_prompt = rmsnorm(xp, final_g)
    y_sample = rmsnorm(xs, final_g)
    return (y_prompt, y_sample, jnp.stack(ckv_p), jnp.stack(kpe_p), jnp.stack(pool_p),
            jnp.stack(ckv_s), jnp.stack(kpe_s), jnp.stack(pool_s))
```

```cpp
#include <hip/hip_runtime.h>
#include <hip/hip_cooperative_groups.h>
#include <cstdio>
#include <cstdint>
namespace cg = cooperative_groups;

#ifndef N_LAUNCH_PER_PHASE
#define N_LAUNCH_PER_PHASE 0
#endif

#define DI __device__ __forceinline__
typedef unsigned short u16;
typedef __attribute__((ext_vector_type(8))) short bf16x8;
typedef __attribute__((ext_vector_type(4))) short s16x4;
typedef __attribute__((ext_vector_type(16))) float f32x16;
typedef __attribute__((ext_vector_type(4))) float f32x4;
typedef __attribute__((ext_vector_type(4))) unsigned u32x4;
typedef __attribute__((ext_vector_type(2))) unsigned u32x2;
typedef __attribute__((ext_vector_type(2))) float f32x2;
typedef __attribute__((ext_vector_type(2))) __bf16 bf16x2_t;

constexpr int D = 4096;
constexpr int TP = 8192;
constexpr int TS = 1024;
constexpr int T = TP + TS;
constexpr int PAST = 1024;
constexpr int SKV = PAST + 64;
constexpr int KVROWS = TP + 16 * SKV;
constexpr int IN_DIM = 3648;
constexpr int IN_PAD = 3712;
constexpr float EPS = 1e-6f;
constexpr int P4K = 4096 + 128, P1K = 1024 + 128, P512 = 512 + 128, P2K = 2048 + 128, PVT = 8192 + 128;
constexpr float QSCALE = 0.07216878364870322f * 1.4426950408889634f;

constexpr size_t O_Y = 0;
constexpr size_t O_CKVP = 37748736;
constexpr size_t O_KPEP = 41943040;
constexpr size_t O_POOLP = 42467328;
constexpr size_t O_CKVS = 42498048;
constexpr size_t O_KPES = 43022336;
constexpr size_t O_POOLS = 43087872;

constexpr size_t WS_CTL = 0;
constexpr size_t WS_RQ = 4096;
constexpr size_t WS_H = WS_RQ + (size_t)T * 4;
constexpr size_t WS_WIN = WS_H + (size_t)T * P4K * 2;
constexpr size_t WS_WUQ = WS_WIN + (size_t)IN_PAD * P4K * 2;
constexpr size_t WS_WUKV = WS_WUQ + (size_t)3072 * P1K * 2;
constexpr size_t WS_WPOOL = WS_WUKV + (size_t)4096 * P512 * 2;
constexpr size_t WS_WO = WS_WPOOL + (size_t)4 * 512 * P512 * 2;
constexpr size_t WS_WPQ = WS_WO + (size_t)4096 * P4K * 2;
constexpr size_t WS_SK = WS_WPQ + (size_t)2048 * P4K * 2;
constexpr size_t WS_U = (WS_SK + (size_t)2 * 8 * 128 * 128 * 2 + ((size_t)2 << 20) - 1) & ~(((size_t)2 << 20) - 1);
constexpr size_t WS_V = WS_U + (size_t)16384 * 4096;
constexpr size_t WS_USC = WS_V + (size_t)16384 * 4096;
constexpr size_t WS_ZQ = WS_USC + (size_t)2 * 16384 * 4;
constexpr size_t WS_ZKV = WS_ZQ + (size_t)T * P1K * 2;
constexpr size_t WS_ZPOOL = WS_ZKV + (size_t)T * 512 * 4;
constexpr size_t WS_CKVA = WS_ZPOOL + (size_t)T * 2048 * 2;
constexpr size_t WS_KPEA = WS_CKVA + (size_t)KVROWS * P512 * 2;
constexpr size_t WS_DPOOL = WS_KPEA + (size_t)KVROWS * 64 * 2;
constexpr size_t WS_Q = WS_DPOOL + (size_t)T * P2K * 2;
constexpr size_t WS_KN = WS_Q + (size_t)T * 3072 * 2;
constexpr size_t WS_VT = WS_KN + (size_t)KVROWS * P2K * 2;
constexpr size_t WS_O = WS_VT + (size_t)16 * 128 * PVT * 2 + (size_t)16 * 16 * 128 * SKV * 2;
constexpr size_t WS_PQ = WS_O + (size_t)T * P4K * 2;
constexpr size_t WS_IDX = WS_PQ + (size_t)T * P2K * 2;
constexpr size_t WS_TOPV = WS_IDX + (size_t)T * 128 * 4;
constexpr size_t WS_END = WS_TOPV + (size_t)T * 128 * 4;

constexpr int LDS_BYTES = 132096;
constexpr int NTHR = 512, NWAVE = 8;

struct Params {
  const float* in[21];
  float* out;
  unsigned char* ws;
  int ph_lo, ph_hi;
};

DI float bf2f(u16 v) { return __uint_as_float(((unsigned)v) << 16); }
DI float bflo(unsigned v) { return __uint_as_float(v << 16); }
DI float bfhi(unsigned v) { return __uint_as_float(v & 0xffff0000u); }
DI unsigned pack_bf16(float a, float b) {
  f32x2 x = {a, b};
  bf16x2_t y = __builtin_convertvector(x, bf16x2_t);
  return __builtin_bit_cast(unsigned, y);
}
DI u16 f2bf(float a) { return (u16)(pack_bf16(a, 0.f) & 0xffffu); }
DI float wave_sum(float v) {
#pragma unroll
  for (int o = 32; o >= 1; o >>= 1) v += __shfl_xor(v, o);
  return v;
}
DI float dpp_f(float v, int ctrl_quad1, int) { return v; }
DI float wave_sum_dpp(float v) {
  v += __builtin_bit_cast(float, __builtin_amdgcn_update_dpp(0, __builtin_bit_cast(int, v), 0xB1, 0xF, 0xF, false));
  v += __builtin_bit_cast(float, __builtin_amdgcn_update_dpp(0, __builtin_bit_cast(int, v), 0x4E, 0xF, 0xF, false));
  v += __builtin_bit_cast(float, __builtin_amdgcn_update_dpp(0, __builtin_bit_cast(int, v), 0x141, 0xF, 0xF, false));
  v += __builtin_bit_cast(float, __builtin_amdgcn_update_dpp(0, __builtin_bit_cast(int, v), 0x140, 0xF, 0xF, false));
  const int b = __builtin_bit_cast(int, v);
  return __builtin_bit_cast(float, __builtin_amdgcn_readlane(b, 0)) + __builtin_bit_cast(float, __builtin_amdgcn_readlane(b, 16)) +
         __builtin_bit_cast(float, __builtin_amdgcn_readlane(b, 32)) + __builtin_bit_cast(float, __builtin_amdgcn_readlane(b, 48));
}
DI int tok_pos(int t) { return t < TP ? t : PAST + ((t - TP) & 63); }
DI int tok_kvrow(int t) { return t < TP ? t : TP + ((t - TP) >> 6) * SKV + PAST + ((t - TP) & 63); }
DI const float* x_row(const Params& p, int t) { return t < TP ? p.in[0] + (size_t)t * D : p.in[1] + (size_t)(t - TP) * D; }
DI f32x16 mfma32(bf16x8 a, bf16x8 b, f32x16 c) { return __builtin_amdgcn_mfma_f32_32x32x16_bf16(a, b, c, 0, 0, 0); }
DI int crow(int reg, int lh) { return (reg & 3) + 8 * (reg >> 2) + 4 * lh; }
DI float rope_inv(int j) { return powf(10000.0f, -(float)j * (1.0f / 32.0f)); }
DI void rope_sc(int pos, float inv, float& s, float& c) {
  float ang = (float)pos * inv;
  double rev = (double)ang * 0.15915494309189535;
  float fr = (float)(rev - rint(rev));
  s = __builtin_amdgcn_sinf(fr); c = __builtin_amdgcn_cosf(fr);
}

DI void convert_span(const float* __restrict__ src, u16* __restrict__ dst, size_t n) {
  size_t nchunk = n >> 3;
  for (size_t c = (size_t)blockIdx.x * NTHR + threadIdx.x; c < nchunk; c += (size_t)gridDim.x * NTHR) {
    f32x4 a = *(const f32x4*)(src + c * 8), b = *(const f32x4*)(src + c * 8 + 4);
    u32x4 o = {pack_bf16(a[0], a[1]), pack_bf16(a[2], a[3]), pack_bf16(b[0], b[1]), pack_bf16(b[2], b[3])};
    *(u32x4*)(dst + c * 8) = o;
  }
}

DI void transpose_job(const float* __restrict__ src, int K, int N, u16* __restrict__ dst, int ldk,
                      const float* __restrict__ kscale, float* tile_base) {
  const int hb = threadIdx.x >> 8, tid = threadIdx.x & 255;
  float* tile = tile_base + hb * (64 * 65);
  const int ntn = N >> 6, ntiles = (K >> 6) * ntn;
  for (int tb = blockIdx.x * 2; tb < ntiles; tb += gridDim.x * 2) {
    const int ti = tb + hb;
    const bool ok = ti < ntiles;
    const int k0 = (ti / ntn) << 6, n0 = (ti % ntn) << 6;
    __syncthreads();
    if (ok) {
#pragma unroll
      for (int i = 0; i < 4; i++) {
        int kk = (tid >> 4) + 16 * i, nn = (tid & 15) * 4;
        f32x4 v = *(const f32x4*)(src + (size_t)(k0 + kk) * N + n0 + nn);
        float sc = kscale ? kscale[k0 + kk] : 1.0f;
        tile[kk * 65 + nn + 0] = v[0] * sc; tile[kk * 65 + nn + 1] = v[1] * sc;
        tile[kk * 65 + nn + 2] = v[2] * sc; tile[kk * 65 + nn + 3] = v[3] * sc;
      }
    }
    __syncthreads();
    if (ok) {
      const int n = tid >> 2, kc = (tid & 3) * 16;
      unsigned o[8];
#pragma unroll
      for (int j = 0; j < 8; j++) o[j] = pack_bf16(tile[(kc + 2 * j) * 65 + n], tile[(kc + 2 * j + 1) * 65 + n]);
      u16* d = dst + (size_t)(n0 + n) * ldk + k0 + kc;
      *(u32x4*)d = (u32x4){o[0], o[1], o[2], o[3]};
      *(u32x4*)(d + 8) = (u32x4){o[4], o[5], o[6], o[7]};
    }
  }
}

DI void phase_prep(const Params& p, char* lds, int rep) {
  const int lane = threadIdx.x & 63, wave = threadIdx.x >> 6;
  float* fl = (float*)lds;
  unsigned char* ws = p.ws;
  if (blockIdx.x == 0 && threadIdx.x < 256) ((unsigned*)(ws + WS_CTL))[threadIdx.x] = 0u;
  {
    const int hb = threadIdx.x >> 8, tid = threadIdx.x & 255;
    const float* g = p.in[5];
    u16* H = (u16*)(ws + WS_H);
    for (int tb = blockIdx.x * 2; tb < T; tb += gridDim.x * 2) {
      const int t = tb + hb;
      const float* x = x_row(p, t);
      f32x4 v[4]; float ss = 0.f;
#pragma unroll
      for (int i = 0; i < 4; i++) { v[i] = *(const f32x4*)(x + tid * 4 + 1024 * i); ss += v[i][0] * v[i][0] + v[i][1] * v[i][1] + v[i][2] * v[i][2] + v[i][3] * v[i][3]; }
      ss = wave_sum(ss);
      __syncthreads();
      if (lane == 0) fl[wave] = ss;
      __syncthreads();
      float tot = fl[hb * 4 + 0] + fl[hb * 4 + 1] + fl[hb * 4 + 2] + fl[hb * 4 + 3];
      float r = rsqrtf(tot * (1.0f / D) + EPS);
#pragma unroll
      for (int i = 0; i < 4; i++) {
        f32x4 gg = *(const f32x4*)(g + tid * 4 + 1024 * i);
        u32x2 o = {pack_bf16(v[i][0] * r * gg[0], v[i][1] * r * gg[1]), pack_bf16(v[i][2] * r * gg[2], v[i][3] * r * gg[3])};
        *(u32x2*)(H + (size_t)t * P4K + tid * 4 + 1024 * i) = o;
      }
    }
  }
  transpose_job(p.in[6], 4096, IN_DIM, (u16*)(ws + WS_WIN), P4K, nullptr, fl);
  transpose_job(p.in[8], 1024, 3072, (u16*)(ws + WS_WUQ), P1K, p.in[7], fl);
  transpose_job(p.in[10], 512, 4096, (u16*)(ws + WS_WUKV), P512, nullptr, fl);
  for (int g = 0; g < 4; g++)
    transpose_job(p.in[11] + (size_t)g * 512 * 512, 512, 512, (u16*)(ws + WS_WPOOL) + (size_t)g * 512 * P512, P512, nullptr, fl);
  transpose_job(p.in[13], 4096, 4096, (u16*)(ws + WS_WO), P4K, nullptr, fl);
  transpose_job(p.in[15], 4096, 2048, (u16*)(ws + WS_WPQ), P4K, p.in[14], fl);
  convert_span(p.in[16], (u16*)(ws + WS_SK), (size_t)8 * 128 * 128);
  convert_span(p.in[17], (u16*)(ws + WS_SK) + 8 * 128 * 128, (size_t)8 * 128 * 128);
  for (int b = 0; b < 16; b++) {
    {
      const float* src = p.in[2] + (size_t)b * PAST * 512;
      u16* dst = (u16*)(ws + WS_CKVA) + (size_t)(TP + b * SKV) * P512;
      for (int c = blockIdx.x * NTHR + threadIdx.x; c < PAST * 64; c += gridDim.x * NTHR) {
        const int r = c >> 6, cc = (c & 63) * 8;
        f32x4 a = *(const f32x4*)(src + (size_t)r * 512 + cc), bb = *(const f32x4*)(src + (size_t)r * 512 + cc + 4);
        *(u32x4*)(dst + (size_t)r * P512 + cc) = (u32x4){pack_bf16(a[0], a[1]), pack_bf16(a[2], a[3]), pack_bf16(bb[0], bb[1]), pack_bf16(bb[2], bb[3])};
      }
    }
    convert_span(p.in[3] + (size_t)b * PAST * 64, (u16*)(ws + WS_KPEA) + (size_t)(TP + b * SKV) * 64, (size_t)PAST * 64);
  }
  {
    float* isc = (float*)(ws + WS_USC);
    for (int r = blockIdx.x * NWAVE + wave; r < 32768; r += gridDim.x * NWAVE) {
      const float* src = r < 16384 ? p.in[18] + (size_t)r * D : p.in[19] + (size_t)(r - 16384) * D;
      unsigned char* dst = ws + WS_U + (size_t)r * D;
      const bool isu = r < 16384;
      f32x4 v[16];
      float am = 0.f;
#pragma unroll
      for (int c = 0; c < 4; c++)
#pragma unroll
        for (int q = 0; q < 4; q++) {
          f32x4 x = *(const f32x4*)(src + (c * 64 + lane) * 16 + 4 * q);
          if (isu) { f32x4 gg = *(const f32x4*)(p.in[14] + (c * 64 + lane) * 16 + 4 * q); x[0] *= gg[0]; x[1] *= gg[1]; x[2] *= gg[2]; x[3] *= gg[3]; }
          v[c * 4 + q] = x;
          am = fmaxf(am, fmaxf(fmaxf(fabsf(x[0]), fabsf(x[1])), fmaxf(fabsf(x[2]), fabsf(x[3]))));
        }
#pragma unroll
      for (int o = 32; o >= 1; o >>= 1) am = fmaxf(am, __shfl_xor(am, o));
      const float sc = am > 0.f ? exp2f(floorf(log2f(240.0f / am))) : 1.0f;
#pragma unroll
      for (int c = 0; c < 4; c++) {
        u32x4 o;
#pragma unroll
        for (int q = 0; q < 4; q++) {
          f32x4 x = v[c * 4 + q];
          int w = __builtin_amdgcn_cvt_pk_fp8_f32(x[0] * sc, x[1] * sc, 0, false);
          w = __builtin_amdgcn_cvt_pk_fp8_f32(x[2] * sc, x[3] * sc, w, true);
          o[q] = (unsigned)w;
        }
        *(u32x4*)(dst + (c * 64 + lane) * 16) = o;
      }
      if (lane == 0) isc[r] = 1.0f / sc;
    }
  }
}

DI int xcd_tile(int it) {
  const int g = gridDim.x;
  if (g & 7) return it * g + blockIdx.x;
  const int per = g >> 3;
  return (it * 8 + (blockIdx.x & 7)) * per + (blockIdx.x >> 3);
}
DI void blocked_order(int idx, int RM, int NTN, int& mp, int& np) {
  const int sr = idx / (RM * NTN), rem = idx - sr * (RM * NTN);
  np = rem / RM; mp = sr * RM + (rem - np * RM);
}

template <int SM, int SN, int WGM, int WGN, class Epi>
DI void gemm8(const u16* __restrict__ A, int lda, const u16* __restrict__ Bt, int ldb, int K,
              int m0, int n0, bool swap, char* lds, Epi&& epi) {
  static_assert(WGM * WGN == 8, "8 waves");
  constexpr int TM = SM * WGM * 32, TN = SN * WGN * 32, LDK = 72;
  constexpr int CA = TM * 8, CB = TN * 8;
  constexpr int PA = (CA + 511) / 512, PB = (CB + 511) / 512;
  constexpr int STAGE = (TM + TN) * LDK;
  static_assert(2 * STAGE * 2 <= LDS_BYTES, "LDS");
  u16* s0 = (u16*)lds;
  const int tid = threadIdx.x, lane = tid & 63, wave = tid >> 6;
  const int wm = wave / WGN, wn = wave % WGN;
  const int lr = lane & 31, lh = lane >> 5;
  const int srow = tid >> 3, skc = (tid & 7) * 8;
  const u16* ga = A + (size_t)(m0 + srow) * lda + skc;
  const u16* gb = Bt + (size_t)(n0 + srow) * ldb + skc;
  u32x4 ra[PA], rb[PB];
  auto gload = [&](int kt) {
#pragma unroll
    for (int i = 0; i < PA; i++)
      if ((CA % 512 == 0) || (tid + 512 * i < CA)) ra[i] = *(const u32x4*)(ga + (size_t)i * 64 * lda + kt * 64);
#pragma unroll
    for (int i = 0; i < PB; i++)
      if ((CB % 512 == 0) || (tid + 512 * i < CB)) rb[i] = *(const u32x4*)(gb + (size_t)i * 64 * ldb + kt * 64);
  };
  auto gwrite = [&](int b) {
    u16* sA = s0 + b * STAGE;
    u16* sB = sA + TM * LDK;
#pragma unroll
    for (int i = 0; i < PA; i++)
      if ((CA % 512 == 0) || (tid + 512 * i < CA)) *(u32x4*)(sA + (srow + 64 * i) * LDK + skc) = ra[i];
#pragma unroll
    for (int i = 0; i < PB; i++)
      if ((CB % 512 == 0) || (tid + 512 * i < CB)) *(u32x4*)(sB + (srow + 64 * i) * LDK + skc) = rb[i];
  };
  f32x16 acc[SM][SN];
#pragma unroll
  for (int i = 0; i < SM; i++)
#pragma unroll
    for (int j = 0; j < SN; j++)
#pragma unroll
      for (int r = 0; r < 16; r++) acc[i][j][r] = 0.f;
  const int offa = (swap ? TM * LDK + (wn * SN * 32) * LDK : (wm * SM * 32) * LDK) + lr * LDK + lh * 8;
  const int offb = (swap ? (wm * SM * 32) * LDK : TM * LDK + (wn * SN * 32) * LDK) + lr * LDK + lh * 8;
  const int nk = K >> 6;
  __syncthreads();
  gload(0);
  gwrite(0);
  if (nk > 1) gload(1);
  __syncthreads();
  for (int kt = 0; kt < nk; kt++) {
    const int cur = kt & 1;
    if (kt + 1 < nk) gwrite(cur ^ 1);
    if (kt + 2 < nk) gload(kt + 2);
    __builtin_amdgcn_sched_barrier(0);
    const u16* pa = s0 + cur * STAGE + offa;
    const u16* pb = s0 + cur * STAGE + offb;
    bf16x8 af[2][SM], bf[2][SN];
#pragma unroll
    for (int i = 0; i < SM; i++) af[0][i] = *(const bf16x8*)(pa + i * 32 * LDK);
#pragma unroll
    for (int j = 0; j < SN; j++) bf[0][j] = *(const bf16x8*)(pb + j * 32 * LDK);
#pragma unroll
    for (int ks = 0; ks < 4; ks++) {
      if (ks < 3) {
#pragma unroll
        for (int i = 0; i < SM; i++) af[(ks + 1) & 1][i] = *(const bf16x8*)(pa + i * 32 * LDK + (ks + 1) * 16);
#pragma unroll
        for (int j = 0; j < SN; j++) bf[(ks + 1) & 1][j] = *(const bf16x8*)(pb + j * 32 * LDK + (ks + 1) * 16);
      }
#pragma unroll
      for (int i = 0; i < SM; i++)
#pragma unroll
        for (int j = 0; j < SN; j++) acc[i][j] = mfma32(af[ks & 1][i], bf[ks & 1][j], acc[i][j]);
    }
    __syncthreads();
  }
  epi(acc, m0 + wm * SM * 32, n0 + wn * SN * 32, lr, lh);
}

DI void phase_inproj(const Params& p, char* lds, int rep) {
  unsigned char* ws = p.ws;
  const u16* H = (const u16*)(ws + WS_H);
  const u16* W = (const u16*)(ws + WS_WIN);
  u16* ZQ = (u16*)(ws + WS_ZQ);
  float* ZKV = (float*)(ws + WS_ZKV);
  u16* ZPOOL = (u16*)(ws + WS_ZPOOL);
  u16* KPEA = (u16*)(ws + WS_KPEA);
  float* out = p.out;
  constexpr int ntn = IN_DIM / 192, ntiles = (T / 256) * ntn;
  for (int it = 0;; it++) {
    const int ti = xcd_tile(it);
    if (ti >= ntiles) break;
    int mp, np;
    blocked_order(ti, 4, ntn, mp, np);
    const int m0 = mp * 256, n0 = np * 192;
    gemm8<2, 3, 4, 2>(H, P4K, W, P4K, D, m0, n0, false, lds, [&](f32x16 (&acc)[2][3], int rb, int cb, int lr, int lh) {
#pragma unroll
      for (int j = 0; j < 3; j++) {
        const int c0 = cb + 32 * j;
        if (c0 < 1024) {
#pragma unroll
          for (int i = 0; i < 2; i++)
#pragma unroll
            for (int r = 0; r < 16; r++) {
              int row = rb + 32 * i + crow(r, lh);
              ZQ[(size_t)row * P1K + c0 + lr] = f2bf(acc[i][j][r]);
            }
        } else if (c0 < 1536) {
#pragma unroll
          for (int i = 0; i < 2; i++)
#pragma unroll
            for (int r = 0; r < 16; r++) {
              int row = rb + 32 * i + crow(r, lh);
              ZKV[(size_t)row * 512 + c0 - 1024 + lr] = acc[i][j][r];
            }
        } else if (c0 == 1536) {
          if (j + 1 < 3) {
            const float inv = rope_inv(lr);
#pragma unroll
            for (int i = 0; i < 2; i++)
#pragma unroll
              for (int r = 0; r < 16; r++) {
                int row = rb + 32 * i + crow(r, lh);
                float s, c;
                rope_sc(tok_pos(row), inv, s, c);
                float x1 = acc[i][j][r], x2 = acc[i][j + 1 < 3 ? j + 1 : j][r];
                float o1 = x1 * c - x2 * s, o2 = x1 * s + x2 * c;
                float* od = row < TP ? out + O_KPEP + (size_t)row * 64 : out + O_KPES + (size_t)(row - TP) * 64;
                od[lr] = o1; od[32 + lr] = o2;
                u16* kd = KPEA + (size_t)tok_kvrow(row) * 64;
                kd[lr] = f2bf(o1); kd[32 + lr] = f2bf(o2);
              }
          }
        } else if (c0 >= 1600 && c0 < IN_DIM) {
#pragma unroll
          for (int i = 0; i < 2; i++)
#pragma unroll
            for (int r = 0; r < 16; r++) {
              int row = rb + 32 * i + crow(r, lh), col = c0 - 1600 + lr;
              float v = acc[i][j][r];
              ZPOOL[(size_t)row * 2048 + col] = f2bf(v);
              if (row < TP) {
                if (row >= TP - 15) out[O_POOLP + (size_t)(row - (TP - 15)) * 2048 + col] = v;
              } else {
                int tt = (row - TP) & 63, b = (row - TP) >> 6;
                if (tt >= 49) out[O_POOLS + (size_t)(b * 15 + tt - 49) * 2048 + col] = v;
              }
            }
        }
      }
    });
  }
}

DI void phase_elem(const Params& p, char* lds, int rep) {
  unsigned char* ws = p.ws;
  const int tid = threadIdx.x, lane = tid & 63, wave = tid >> 6;
  const u16* ZQ = (const u16*)(ws + WS_ZQ);
  const float* ZKV = (const float*)(ws + WS_ZKV);
  const u16* ZPOOL = (const u16*)(ws + WS_ZPOOL);
  float* RQ = (float*)(ws + WS_RQ);
  u16* CKVA = (u16*)(ws + WS_CKVA);
  u16* DPOOL = (u16*)(ws + WS_DPOOL);
  const float* gkv = p.in[9];
  const float* hist = p.in[4];
  float* out = p.out;
  for (int t = blockIdx.x * NWAVE + wave; t < T; t += gridDim.x * NWAVE) {
    u32x4 zq[2];
    f32x4 zk[2], gk[2];
#pragma unroll
    for (int i = 0; i < 2; i++) {
      zq[i] = *(const u32x4*)(ZQ + (size_t)t * P1K + lane * 8 + 512 * i);
      zk[i] = *(const f32x4*)(ZKV + (size_t)t * 512 + lane * 4 + 256 * i);
      gk[i] = *(const f32x4*)(gkv + lane * 4 + 256 * i);
    }
    u32x4 po[4];
    {
      const bool samp = t >= TP;
      const int tt = samp ? ((t - TP) & 63) : t;
      const int b = samp ? ((t - TP) >> 6) : 0;
      if (tt >= 15) {
#pragma unroll
        for (int g = 0; g < 4; g++) {
          const int w = 2 << g;
          const int ch = g * 512 + lane * 8;
          float s[8], cur[8];
#pragma unroll
          for (int e = 0; e < 8; e++) s[e] = 0.f;
#pragma unroll
          for (int j = 0; j < w; j++) {
            u32x4 v = *(const u32x4*)(ZPOOL + (size_t)(t - j) * 2048 + ch);
#pragma unroll
            for (int e = 0; e < 4; e++) {
              float a = bflo(v[e]), bb = bfhi(v[e]);
              s[2 * e] += a; s[2 * e + 1] += bb;
              if (j == 0) { cur[2 * e] = a; cur[2 * e + 1] = bb; }
            }
          }
          const float ic = 1.0f / (float)w;
          po[g] = (u32x4){pack_bf16(s[0] * ic - cur[0], s[1] * ic - cur[1]), pack_bf16(s[2] * ic - cur[2], s[3] * ic - cur[3]),
                          pack_bf16(s[4] * ic - cur[4], s[5] * ic - cur[5]), pack_bf16(s[6] * ic - cur[6], s[7] * ic - cur[7])};
        }
      } else {
#pragma unroll
        for (int g = 0; g < 4; g++) {
          const int w = 2 << g;
          const int ch = g * 512 + lane * 8;
          float s[8];
#pragma unroll
          for (int e = 0; e < 8; e++) s[e] = 0.f;
          float cur[8];
          int cnt = 0;
          for (int j = 0; j < w; j++) {
            int r = tt - j;
            if (r >= 0) {
              u32x4 v = *(const u32x4*)(ZPOOL + (size_t)(t - j) * 2048 + ch);
#pragma unroll
              for (int e = 0; e < 4; e++) {
                float a = bflo(v[e]), bb = bfhi(v[e]);
                s[2 * e] += a; s[2 * e + 1] += bb;
                if (j == 0) { cur[2 * e] = a; cur[2 * e + 1] = bb; }
              }
              cnt++;
            } else if (samp) {
              const float* hp = hist + ((size_t)b * 15 + (15 + r)) * 2048 + ch;
              f32x4 a = *(const f32x4*)hp, bb = *(const f32x4*)(hp + 4);
              s[0] += a[0]; s[1] += a[1]; s[2] += a[2]; s[3] += a[3];
              s[4] += bb[0]; s[5] += bb[1]; s[6] += bb[2]; s[7] += bb[3];
              cnt++;
            }
          }
          float ic = 1.0f / (float)cnt;
          po[g] = (u32x4){pack_bf16(s[0] * ic - cur[0], s[1] * ic - cur[1]), pack_bf16(s[2] * ic - cur[2], s[3] * ic - cur[3]),
                          pack_bf16(s[4] * ic - cur[4], s[5] * ic - cur[5]), pack_bf16(s[6] * ic - cur[6], s[7] * ic - cur[7])};
        }
      }
    }
    float ssq = 0.f, ssk = 0.f;
#pragma unroll
    for (int i = 0; i < 2; i++) {
#pragma unroll
      for (int e = 0; e < 4; e++) { float a = bflo(zq[i][e]), bq = bfhi(zq[i][e]); ssq += a * a + bq * bq; }
      ssk += zk[i][0] * zk[i][0] + zk[i][1] * zk[i][1] + zk[i][2] * zk[i][2] + zk[i][3] * zk[i][3];
    }
    ssq = wave_sum(ssq);
    ssk = wave_sum(ssk);
    const float rk = rsqrtf(ssk * (1.0f / 512) + EPS);
    if (lane == 0) RQ[t] = rsqrtf(ssq * (1.0f / 1024) + EPS);
    float* od = t < TP ? out + O_CKVP + (size_t)t * 512 : out + O_CKVS + (size_t)(t - TP) * 512;
    u16* cd = CKVA + (size_t)tok_kvrow(t) * P512;
#pragma unroll
    for (int i = 0; i < 2; i++) {
      f32x4 o = {zk[i][0] * rk * gk[i][0], zk[i][1] * rk * gk[i][1], zk[i][2] * rk * gk[i][2], zk[i][3] * rk * gk[i][3]};
      *(f32x4*)(od + lane * 4 + 256 * i) = o;
      *(u32x2*)(cd + lane * 4 + 256 * i) = (u32x2){pack_bf16(o[0], o[1]), pack_bf16(o[2], o[3])};
    }
#pragma unroll
    for (int g = 0; g < 4; g++) *(u32x4*)(DPOOL + (size_t)t * P2K + g * 512 + lane * 8) = po[g];
  }
}

DI void phase_upproj(const Params& p, char* lds, int rep) {
  unsigned char* ws = p.ws;
  constexpr int NT_Q = (T / 256) * 24;
  constexpr int NT_KV = (KVROWS / 256) * 32;
  constexpr int NT_PL = (T / 256) * 16;
  const float* RQ = (const float*)(ws + WS_RQ);
  u16* Q = (u16*)(ws + WS_Q);
  u16* KN = (u16*)(ws + WS_KN);
  u16* VTP = (u16*)(ws + WS_VT);
  u16* VTS = VTP + (size_t)16 * 128 * PVT;
  u16* O = (u16*)(ws + WS_O);
  const float* pscale = p.in[12];
  for (int it = 0;; it++) {
    const int ti = xcd_tile(it);
    if (ti >= NT_Q + NT_KV + NT_PL) break;
    int mp, np;
    if (ti < NT_Q) {
      blocked_order(ti, 4, 24, mp, np);
      const int m0 = mp * 256, n0 = np * 128;
      gemm8<2, 2, 4, 2>((const u16*)(ws + WS_ZQ), P1K, (const u16*)(ws + WS_WUQ), P1K, 1024, m0, n0, false, lds,
                [&](f32x16 (&acc)[2][2], int rb, int cb, int lr, int lh) {
        const bool isrope = (cb % 192) == 128;
        const float inv = rope_inv(lr);
        float rqv[2][16];
#pragma unroll
        for (int i = 0; i < 2; i++)
#pragma unroll
          for (int r = 0; r < 16; r++) rqv[i][r] = RQ[rb + 32 * i + crow(r, lh)];
#pragma unroll
        for (int i = 0; i < 2; i++)
#pragma unroll
          for (int r = 0; r < 16; r++) {
            int row = rb + 32 * i + crow(r, lh);
            float rq = rqv[i][r];
            float x1 = acc[i][0][r] * rq, x2 = acc[i][1][r] * rq;
            if (isrope) {
              float s, c;
              rope_sc(tok_pos(row), inv, s, c);
              float o1 = x1 * c - x2 * s, o2 = x1 * s + x2 * c;
              x1 = o1; x2 = o2;
            }
            Q[(size_t)row * 3072 + cb + lr] = f2bf(x1 * QSCALE);
            Q[(size_t)row * 3072 + cb + 32 + lr] = f2bf(x2 * QSCALE);
          }
      });
    } else if (ti < NT_Q + NT_KV) {
      const int tj = ti - NT_Q;
      blocked_order(tj, 4, 32, mp, np);
      const int m0 = mp * 256, n0 = np * 128;
      const int wn = (threadIdx.x >> 6) & 1;
      const bool swap = ((n0 + wn * 64) & 255) >= 128;
      gemm8<2, 2, 4, 2>((const u16*)(ws + WS_CKVA), P512, (const u16*)(ws + WS_WUKV), P512, 512, m0, n0, swap, lds,
                [&](f32x16 (&acc)[2][2], int rb, int cb, int lr, int lh) {
        const int head = cb >> 8;
        if (!swap) {
#pragma unroll
          for (int i = 0; i < 2; i++)
#pragma unroll
            for (int j = 0; j < 2; j++)
#pragma unroll
              for (int r = 0; r < 16; r++) {
                int row = rb + 32 * i + crow(r, lh), col = (cb & 255) + 32 * j + lr;
                KN[(size_t)row * P2K + head * 128 + col] = f2bf(acc[i][j][r]);
              }
        } else {
#pragma unroll
          for (int i = 0; i < 2; i++)
#pragma unroll
            for (int j = 0; j < 2; j++)
#pragma unroll
              for (int r = 0; r < 16; r++) {
                int vd = (cb & 255) - 128 + 32 * i + crow(r, lh);
                int tok = rb + 32 * j + lr;
                u16* dst;
                if (tok < TP) dst = VTP + ((size_t)(head * 128 + vd)) * PVT + tok;
                else { int rr = tok - TP; int b = rr / SKV, s = rr - b * SKV; dst = VTS + ((size_t)((b * 16 + head) * 128 + vd)) * SKV + s; }
                *dst = f2bf(acc[i][j][r]);
              }
        }
      });
    } else {
      const int tj = ti - NT_KV - NT_Q;
      blocked_order(tj, 4, 16, mp, np);
      const int m0 = mp * 256, g = np >> 2, n0 = (np & 3) * 128;
      gemm8<2, 2, 4, 2>((const u16*)(ws + WS_DPOOL) + g * 512, P2K, (const u16*)(ws + WS_WPOOL) + (size_t)g * 512 * P512, P512, 512, m0, n0, false, lds,
                [&](f32x16 (&acc)[2][2], int rb, int cb, int lr, int lh) {
#pragma unroll
        for (int j = 0; j < 2; j++) {
          int col = g * 512 + cb + 32 * j + lr;
          float sc = pscale[col];
#pragma unroll
          for (int i = 0; i < 2; i++)
#pragma unroll
            for (int r = 0; r < 16; r++) {
              int row = rb + 32 * i + crow(r, lh);
              O[(size_t)row * P4K + 2048 + col] = f2bf(acc[i][j][r] * sc);
            }
        }
      });
    }
  }
}

DI void phase_attn(const Params& p, char* lds, int rep) {
  unsigned char* ws = p.ws;
  const int tid = threadIdx.x, lane = tid & 63, wave = tid >> 6;
  const int lr = lane & 31, lh = lane >> 5;
  const u16* Q = (const u16*)(ws + WS_Q);
  const u16* KN = (const u16*)(ws + WS_KN);
  const u16* KPEA = (const u16*)(ws + WS_KPEA);
  const u16* VTP = (const u16*)(ws + WS_VT);
  const u16* VTS = VTP + (size_t)16 * 128 * PVT;
  u16* O = (u16*)(ws + WS_O);
  const int xq = blockIdx.x & 7;
  unsigned* ctr = (unsigned*)(ws + WS_CTL) + rep * 8 + xq;
  constexpr int KB = 64 * 200, VB = 128 * 68, BUF = KB + VB;
  u16* sbuf = (u16*)lds;
  int* sItem = (int*)(sbuf + 2 * BUF);
  constexpr int NITEM = 64 + 32;
  while (true) {
    __syncthreads();
    if (tid == 0) *sItem = (int)atomicAdd(ctr, 1u);
    __syncthreads();
    const int qi = *sItem;
    if (qi >= NITEM) break;
    const int item = qi < 64 ? ((qi >> 1) << 4) + xq + 8 * (qi & 1) : 512 + (((qi - 64) >> 1) << 4) + xq + 8 * ((qi - 64) & 1);
    int h, q0, kvbase, vstride, ntile, my_ntile;
    bool active;
    const u16* vt;
    if (item < 512) {
      const int qb = 31 - (item >> 4);
      h = item & 15; q0 = qb * 256; kvbase = 0; vt = VTP + (size_t)h * 128 * PVT; vstride = PVT;
      ntile = 4 * qb + 4; my_ntile = 4 * qb + 1 + (wave >> 1); active = true;
    } else {
      const int j = item - 512, b = j >> 4;
      h = j & 15; q0 = TP + b * 64; kvbase = TP + b * SKV; vt = VTS + (size_t)((b * 16 + h) * 128) * SKV; vstride = SKV;
      ntile = 17; my_ntile = 17; active = wave < 2;
    }
    const int qrow = q0 + 32 * (active ? wave : (wave & 1)) + lr;
    bf16x8 qf[12];
    {
      const u16* qp = Q + (size_t)qrow * 3072 + h * 192 + lh * 8;
#pragma unroll
      for (int s = 0; s < 12; s++) qf[s] = *(const bf16x8*)(qp + 16 * s);
    }
    f32x16 ot[4];
#pragma unroll
    for (int d = 0; d < 4; d++)
#pragma unroll
      for (int r = 0; r < 16; r++) ot[d][r] = 0.f;
    float m_run = -INFINITY, l_run = 0.f;
    u32x4 rkn[2], rkp, rvv[2];
    auto stage_load = [&](int kt) {
      const size_t kr0 = (size_t)kvbase + kt * 64;
#pragma unroll
      for (int i = 0; i < 2; i++) {
        int c = tid + 512 * i, key = c >> 4, ch = c & 15;
        rkn[i] = *(const u32x4*)(KN + (kr0 + key) * P2K + h * 128 + ch * 8);
      }
      { int key = tid >> 3, ch = tid & 7; rkp = *(const u32x4*)(KPEA + (kr0 + key) * 64 + ch * 8); }
#pragma unroll
      for (int i = 0; i < 2; i++) {
        int c = tid + 512 * i, vd = c >> 3, ch = c & 7;
        rvv[i] = *(const u32x4*)(vt + (size_t)vd * vstride + kt * 64 + ch * 8);
      }
    };
    auto stage_write = [&](int b) {
      u16* sK = sbuf + b * BUF;
      u16* sV = sK + KB;
#pragma unroll
      for (int i = 0; i < 2; i++) {
        int c = tid + 512 * i, key = c >> 4, ch = c & 15;
        *(u32x4*)(sK + key * 200 + ch * 8) = rkn[i];
      }
      { int key = tid >> 3, ch = tid & 7; *(u32x4*)(sK + key * 200 + 128 + ch * 8) = rkp; }
#pragma unroll
      for (int i = 0; i < 2; i++) {
        int c = tid + 512 * i, vd = c >> 3, ch = c & 7;
        u16* d = sV + vd * 68 + ch * 8;
        *(u32x2*)d = (u32x2){rvv[i][0], rvv[i][1]};
        *(u32x2*)(d + 4) = (u32x2){rvv[i][2], rvv[i][3]};
      }
    };
    stage_load(0);
    stage_write(0);
    if (ntile > 1) stage_load(1);
    __syncthreads();
    for (int kt = 0; kt < ntile; kt++) {
      if (kt + 1 < ntile) stage_write((kt + 1) & 1);
      if (kt + 2 < ntile) stage_load(kt + 2);
      __builtin_amdgcn_sched_barrier(0);
      if (active && kt < my_ntile) {
        const u16* sK = sbuf + (kt & 1) * BUF;
        const u16* sV = sK + KB;
        f32x16 st[2];
#pragma unroll
        for (int t2 = 0; t2 < 2; t2++)
#pragma unroll
          for (int r = 0; r < 16; r++) st[t2][r] = 0.f;
#pragma unroll
        for (int s = 0; s < 12; s++) {
#pragma unroll
          for (int t2 = 0; t2 < 2; t2++) {
            bf16x8 kf = *(const bf16x8*)(sK + (32 * t2 + lr) * 200 + 16 * s + 8 * lh);
            st[t2] = mfma32(kf, qf[s], st[t2]);
          }
        }
        float mx = st[0][0];
#pragma unroll
        for (int t2 = 0; t2 < 2; t2++)
#pragma unroll
          for (int r = 0; r < 16; r++) mx = fmaxf(mx, st[t2][r]);
        mx = fmaxf(mx, __shfl_xor(mx, 32));
        constexpr float THR = 10.0f;
        if (__any(mx - m_run > THR)) {
          const float m_new = fmaxf(m_run, mx);
          const float alpha = __builtin_amdgcn_exp2f(m_run - m_new);
          m_run = m_new;
          l_run *= alpha;
#pragma unroll
          for (int d = 0; d < 4; d++)
#pragma unroll
            for (int r = 0; r < 16; r++) ot[d][r] *= alpha;
        }
        float ps = 0.f;
#pragma unroll
        for (int t2 = 0; t2 < 2; t2++)
#pragma unroll
          for (int r = 0; r < 16; r++) { float e = __builtin_amdgcn_exp2f(st[t2][r] - m_run); st[t2][r] = e; ps += e; }
        l_run += ps;
        bf16x8 pf[2][2];
#pragma unroll
        for (int t2 = 0; t2 < 2; t2++)
#pragma unroll
          for (int s2 = 0; s2 < 2; s2++) {
            u32x4 pk = {pack_bf16(st[t2][8 * s2 + 0], st[t2][8 * s2 + 1]), pack_bf16(st[t2][8 * s2 + 2], st[t2][8 * s2 + 3]),
                        pack_bf16(st[t2][8 * s2 + 4], st[t2][8 * s2 + 5]), pack_bf16(st[t2][8 * s2 + 6], st[t2][8 * s2 + 7])};
            pf[t2][s2] = __builtin_bit_cast(bf16x8, pk);
          }
#pragma unroll
        for (int d = 0; d < 4; d++)
#pragma unroll
          for (int t2 = 0; t2 < 2; t2++)
#pragma unroll
            for (int s2 = 0; s2 < 2; s2++) {
              const u16* vb = sV + (32 * d + lr) * 68 + 32 * t2 + 16 * s2 + 4 * lh;
              u32x2 lo = *(const u32x2*)vb, hi = *(const u32x2*)(vb + 8);
              u32x4 vv = {lo[0], lo[1], hi[0], hi[1]};
              ot[d] = mfma32(__builtin_bit_cast(bf16x8, vv), pf[t2][s2], ot[d]);
            }
      }
      __syncthreads();
    }
    if (active) {
      float lt = l_run + __shfl_xor(l_run, 32);
      float inv = 1.0f / lt;
      u16* od = O + (size_t)qrow * P4K + h * 128 + 4 * lh;
#pragma unroll
      for (int d = 0; d < 4; d++)
#pragma unroll
        for (int g = 0; g < 4; g++) {
          u32x2 o = {pack_bf16(ot[d][4 * g] * inv, ot[d][4 * g + 1] * inv), pack_bf16(ot[d][4 * g + 2] * inv, ot[d][4 * g + 3] * inv)};
          *(u32x2*)(od + 32 * d + 8 * g) = o;
        }
    }
  }
}

DI void phase_outproj(const Params& p, char* lds, int rep) {
  unsigned char* ws = p.ws;
  float* X1 = p.out + O_Y;
  u16* X1B = (u16*)(ws + WS_H);
  constexpr int ntiles = (T / 192) * 16;
  for (int it = 0;; it++) {
    const int ti = xcd_tile(it);
    if (ti >= ntiles) break;
    int mp, np;
    blocked_order(ti, 4, 16, mp, np);
    const int m0 = mp * 192, n0 = np * 256;
    gemm8<3, 2, 2, 4>((const u16*)(ws + WS_O), P4K, (const u16*)(ws + WS_WO), P4K, D, m0, n0, false, lds,
              [&](f32x16 (&acc)[3][2], int rb, int cb, int lr, int lh) {
#pragma unroll
      for (int i = 0; i < 3; i++) {
        float xv[2][16];
#pragma unroll
        for (int j = 0; j < 2; j++)
#pragma unroll
          for (int r = 0; r < 16; r++) xv[j][r] = x_row(p, rb + 32 * i + crow(r, lh))[cb + 32 * j + lr];
#pragma unroll
        for (int j = 0; j < 2; j++)
#pragma unroll
          for (int r = 0; r < 16; r++) {
            int row = rb + 32 * i + crow(r, lh), col = cb + 32 * j + lr;
            float v = xv[j][r] + acc[i][j][r];
            X1[(size_t)row * D + col] = v;
            X1B[(size_t)row * P4K + col] = f2bf(v);
          }
      }
    });
  }
}

DI void wait_cnt(unsigned* c, unsigned need) {
  if (threadIdx.x == 0) {
    while (__hip_atomic_load(c, __ATOMIC_RELAXED, __HIP_MEMORY_SCOPE_AGENT) < need) __builtin_amdgcn_s_sleep(8);
    __threadfence();
  }
  __syncthreads();
}
DI void signal_cnt(unsigned* c) {
  __syncthreads();
  if (threadIdx.x == 0) { __threadfence(); atomicAdd(c, 1u); }
}
constexpr int CW_Q7 = 16, CW_G6M = 64;

DI void phase_peerq(const Params& p, char* lds, int rep) {
  unsigned char* ws = p.ws;
  u16* PQ = (u16*)(ws + WS_PQ);
  constexpr int ntiles = (T / 192) * 8;
  for (int it = 0;; it++) {
    const int ti = xcd_tile(it);
    if (ti >= ntiles) break;
    int mp, np;
    blocked_order(ti, 4, 8, mp, np);
    const int m0 = mp * 192, n0 = np * 256;
    gemm8<3, 2, 2, 4>((const u16*)(ws + WS_H), P4K, (const u16*)(ws + WS_WPQ), P4K, D, m0, n0, false, lds,
              [&](f32x16 (&acc)[3][2], int rb, int cb, int lr, int lh) {
#pragma unroll
      for (int i = 0; i < 3; i++)
#pragma unroll
        for (int j = 0; j < 2; j++)
#pragma unroll
          for (int r = 0; r < 16; r++) {
            int row = rb + 32 * i + crow(r, lh), col = cb + 32 * j + lr;
            PQ[(size_t)row * P2K + col] = f2bf(acc[i][j][r]);
          }
    });
    signal_cnt((unsigned*)(ws + WS_CTL) + CW_G6M + mp);
  }
}

DI void topk_insert(float (&L)[16], float pv) {
  if (pv > L[15]) {
#pragma unroll
    for (int i = 15; i >= 1; i--) L[i] = __builtin_amdgcn_fmed3f(pv, L[i - 1], L[i]);
    L[0] = fmaxf(pv, L[0]);
  }
}

DI void phase_topk(const Params& p, char* lds, int rep) {
  unsigned char* ws = p.ws;
  const int tid = threadIdx.x, lane = tid & 63, wave = tid >> 6;
  const int lr = lane & 31, lh = lane >> 5;
  const u16* PQ = (const u16*)(ws + WS_PQ);
  const u16* SK = (const u16*)(ws + WS_SK);
  int* IDX = (int*)(ws + WS_IDX);
  float* TOPV = (float*)(ws + WS_TOPV);
  float* S = (float*)lds;
  const int nitem = (T / 128) * 8;
  unsigned* cw = (unsigned*)(ws + WS_CTL);
  int* sItem = (int*)(lds + LDS_BYTES - 16);
  while (true) {
    __syncthreads();
    if (tid == 0) *sItem = (int)atomicAdd(cw + CW_Q7, 1u);
    __syncthreads();
    const int it = *sItem;
    if (it >= nitem) break;
    const int t0 = (it >> 3) * 128, h = it & 7;
    {
      const int ma = t0 / 192, mb = (t0 + 127) / 192;
      wait_cnt(cw + CW_G6M + ma, 8);
      if (mb != ma) wait_cnt(cw + CW_G6M + mb, 8);
    }
    const int th = wave >> 2, half = (wave >> 1) & 1, nb = (wave & 1) * 64;
    f32x16 acc[2][2];
#pragma unroll
    for (int i = 0; i < 2; i++)
#pragma unroll
      for (int j = 0; j < 2; j++)
#pragma unroll
        for (int r = 0; r < 16; r++) acc[i][j][r] = 0.f;
    const u16* ap = PQ + (size_t)(t0 + th * 64 + lr) * P2K + h * 256 + half * 128 + lh * 8;
    const u16* bp = SK + ((size_t)(half * 8 + h) * 128 + nb + lr) * 128 + lh * 8;
#pragma unroll
    for (int ks = 0; ks < 8; ks++) {
      bf16x8 a0 = *(const bf16x8*)(ap + ks * 16), a1 = *(const bf16x8*)(ap + (size_t)32 * P2K + ks * 16);
      bf16x8 b0 = *(const bf16x8*)(bp + ks * 16), b1 = *(const bf16x8*)(bp + 32 * 128 + ks * 16);
      acc[0][0] = mfma32(a0, b0, acc[0][0]);
      acc[0][1] = mfma32(a0, b1, acc[0][1]);
      acc[1][0] = mfma32(a1, b0, acc[1][0]);
      acc[1][1] = mfma32(a1, b1, acc[1][1]);
    }
    __syncthreads();
#pragma unroll
    for (int i = 0; i < 2; i++)
#pragma unroll
      for (int j = 0; j < 2; j++)
#pragma unroll
        for (int r = 0; r < 16; r++) {
          int row = th * 64 + 32 * i + crow(r, lh), col = half * 128 + nb + 32 * j + lr;
          S[row * 257 + col] = acc[i][j][r];
        }
    __syncthreads();
    if (tid < 256) {
      const int tok = tid & 127, hf = tid >> 7;
      float* sp = S + tok * 257 + hf * 128;
      float L[16];
#pragma unroll
      for (int i = 0; i < 16; i++) L[i] = -INFINITY;
      for (int j = 0; j < 128; j++) {
        float pv = __uint_as_float((__float_as_uint(sp[j]) & 0xFFFFFF80u) | (unsigned)j);
        topk_insert(L, pv);
      }
#pragma unroll
      for (int i = 0; i < 16; i++) sp[i] = L[i];
    }
    __syncthreads();
    if (tid < 128) {
      const int tok = tid;
      const float* s1 = S + tok * 257;
      const float* s2 = s1 + 128;
      float v1[16], v2[16];
#pragma unroll
      for (int i = 0; i < 16; i++) { v1[i] = s1[i]; v2[i] = s2[i]; }
      float L[16];
#pragma unroll
      for (int i = 0; i < 16; i++) L[i] = -INFINITY;
#pragma unroll
      for (int a = 0; a < 16; a++)
#pragma unroll
        for (int b = 0; b < 16; b++)
          if ((a + 1) * (b + 1) <= 16) {
            float c = v1[a] + v2[b];
            float pv = __uint_as_float((__float_as_uint(c) & 0xFFFFFF00u) | (unsigned)(a * 16 + b));
            topk_insert(L, pv);
          }
      const size_t ob = (size_t)(t0 + tok) * 128 + h * 16;
#pragma unroll
      for (int i = 0; i < 16; i++) {
        unsigned bits = __float_as_uint(L[i]);
        int a = (bits >> 4) & 15, b = bits & 15;
        int i1 = __float_as_uint(s1[a]) & 127, i2 = __float_as_uint(s2[b]) & 127;
        IDX[ob + i] = i1 * 128 + i2;
        TOPV[ob + i] = __uint_as_float(bits & 0xFFFFFF00u);
      }
    }
    __syncthreads();
  }
}

DI f32x2 dot16_fp8(u32x4 w, const float* hv, f32x2 s) {
#pragma unroll
  for (int q = 0; q < 4; q++) {
    f32x2 lo = __builtin_amdgcn_cvt_pk_f32_fp8((int)w[q], false), hi = __builtin_amdgcn_cvt_pk_f32_fp8((int)w[q], true);
    f32x2 h0 = {hv[4 * q], hv[4 * q + 1]}, h1 = {hv[4 * q + 2], hv[4 * q + 3]};
    s = __builtin_elementwise_fma(lo, h0, s);
    s = __builtin_elementwise_fma(hi, h1, s);
  }
  return s;
}

DI void phase_peer(const Params& p, char* lds, int rep) {
  unsigned char* ws = p.ws;
  const int tid = threadIdx.x, lane = tid & 63, wave = (tid >> 6) & 3, hb = tid >> 8;
  const unsigned char* U8 = ws + WS_U;
  const unsigned char* V8 = ws + WS_V;
  const float* USC = (const float*)(ws + WS_USC);
  const float* VSC = USC + 16384;
  const int* IDX = (const int*)(ws + WS_IDX);
  const float* TOPV = (const float*)(ws + WS_TOPV);
  const float* g2 = p.in[14];
  const float* gf = p.in[20];
  float* s_act = (float*)lds + hb * 320;
  int* s_idx = (int*)(s_act + 128);
  float* s_red = (float*)(s_idx + 128);
  float* xs = (float*)lds + 1024 + hb * D;
  const int cbase = wave * 1024 + lane * 16;
  const int k = wave * 32 + (lane & 31);
  const int tl = tid & 255;
  const int tstride = gridDim.x * 2;
  constexpr int NB = 4;
  u32x4 ring[NB][4];
  f32x4 xr[4];
  int myidx = 0;
  float tv = 0.f;
  int t = blockIdx.x * 2 + hb;
  if (t < T) {
    const float* xrow0 = p.out + O_Y + (size_t)t * D;
#pragma unroll
    for (int q = 0; q < 4; q++) xr[q] = *(const f32x4*)(xrow0 + tl * 4 + 1024 * q);
    myidx = IDX[(size_t)t * 128 + k];
    tv = TOPV[(size_t)t * 128 + k];
#pragma unroll
    for (int rr = 0; rr < 2; rr++) {
      const unsigned char* rp = U8 + (size_t)__builtin_amdgcn_readlane(myidx, rr) * D + lane * 16;
#pragma unroll
      for (int c = 0; c < 4; c++) ring[rr][c] = *(const u32x4*)(rp + c * 1024);
    }
  }
  for (; t < T; t += tstride) {
    float* xrow = p.out + O_Y + (size_t)t * D;
    const float usc = USC[myidx], vsc = VSC[myidx];
    {
      const unsigned char* rp = U8 + (size_t)__builtin_amdgcn_readlane(myidx, 2) * D + lane * 16;
#pragma unroll
      for (int c = 0; c < 4; c++) ring[2][c] = *(const u32x4*)(rp + c * 1024);
    }
    if (lane < 32) s_idx[k] = myidx;
    {
      __syncthreads();
#pragma unroll
      for (int q = 0; q < 4; q++) *(f32x4*)(xs + tl * 4 + 1024 * q) = xr[q];
      __syncthreads();
    }
    float hv[64];
    float ss = 0.f;
#pragma unroll
    for (int c = 0; c < 4; c++)
#pragma unroll
      for (int q = 0; q < 4; q++) {
        f32x4 a = *(const f32x4*)(xs + (c * 64 + lane) * 16 + 4 * q);
        hv[c * 16 + q * 4 + 0] = a[0]; hv[c * 16 + q * 4 + 1] = a[1]; hv[c * 16 + q * 4 + 2] = a[2]; hv[c * 16 + q * 4 + 3] = a[3];
      }
#pragma unroll
    for (int i = 0; i < 64; i++) ss += hv[i] * hv[i];
    float a_mine = 0.f;
    for (int j = 0; j < 32; j += NB) {
#pragma unroll
      for (int i = 0; i < NB; i++) {
        const int r = j + i;
        if (r + NB - 1 < 32) {
          const unsigned char* rp = U8 + (size_t)__builtin_amdgcn_readlane(myidx, r + NB - 1) * D + lane * 16;
#pragma unroll
          for (int c = 0; c < 4; c++) ring[(i + NB - 1) % NB][c] = *(const u32x4*)(rp + c * 1024);
        }
        f32x2 sp = {0.f, 0.f};
#pragma unroll
        for (int c = 0; c < 4; c++) sp = dot16_fp8(ring[i][c], &hv[c * 16], sp);
        float s0 = wave_sum_dpp(sp[0] + sp[1]);
        if ((lane & 31) == r) a_mine = s0;
      }
    }
    ss = wave_sum(ss);
    const float r2 = rsqrtf(ss * (1.0f / D) + EPS);
    float z = tv * r2;
    float m = z;
#pragma unroll
    for (int o = 8; o >= 1; o >>= 1) m = fmaxf(m, __shfl_xor(m, o));
    float e = __expf(z - m);
    float se = e;
#pragma unroll
    for (int o = 8; o >= 1; o >>= 1) se += __shfl_xor(se, o);
    const float gate = e / se;
    a_mine *= usc * r2;
    const float act = 0.5f * a_mine * (1.0f + erff(a_mine * 0.7071067811865476f)) * gate * vsc;
    constexpr int VPRE = 8;
    u32x4 vpre[VPRE];
#pragma unroll
    for (int kk = 0; kk < VPRE; kk++) vpre[kk] = *(const u32x4*)(V8 + (size_t)s_idx[kk] * D + cbase);
    if (lane < 32) s_act[k] = act;
    __syncthreads();
    const int tn = t + tstride;
    const bool has_next = tn < T;
    f32x4 nxr[4];
    int nidx = 0;
    float ntv = 0.f;
    if (has_next) {
      const float* xrown = p.out + O_Y + (size_t)tn * D;
#pragma unroll
      for (int q = 0; q < 4; q++) nxr[q] = *(const f32x4*)(xrown + tl * 4 + 1024 * q);
      nidx = IDX[(size_t)tn * 128 + k];
      ntv = TOPV[(size_t)tn * 128 + k];
    }
    f32x2 y2[8];
#pragma unroll
    for (int i = 0; i < 8; i++) y2[i] = (f32x2){0.f, 0.f};
    u32x4 vb1[VPRE];
    auto vload = [&](u32x4 (&dst)[VPRE], int g) __attribute__((always_inline)) {
#pragma unroll
      for (int kk = 0; kk < VPRE; kk++) dst[kk] = *(const u32x4*)(V8 + (size_t)s_idx[g * VPRE + kk] * D + cbase);
    };
    auto vuse = [&](const u32x4 (&src)[VPRE], int g) __attribute__((always_inline)) {
#pragma unroll
      for (int kk = 0; kk < VPRE; kk++) {
        const float av = s_act[g * VPRE + kk];
        const f32x2 av2 = {av, av};
        const u32x4 w = src[kk];
#pragma unroll
        for (int q = 0; q < 4; q++) {
          f32x2 lo = __builtin_amdgcn_cvt_pk_f32_fp8((int)w[q], false), hi = __builtin_amdgcn_cvt_pk_f32_fp8((int)w[q], true);
          y2[2 * q] = __builtin_elementwise_fma(av2, lo, y2[2 * q]);
          y2[2 * q + 1] = __builtin_elementwise_fma(av2, hi, y2[2 * q + 1]);
        }
      }
    };
    vload(vb1, 1);
#pragma unroll 1
    for (int g = 0; g < 128 / VPRE; g += 2) {
      vuse(vpre, g);
      if (g + 2 < 128 / VPRE) vload(vpre, g + 2);
      vuse(vb1, g + 1);
      if (g + 3 < 128 / VPRE) vload(vb1, g + 3);
    }
    if (has_next) {
#pragma unroll
      for (int rr = 0; rr < 2; rr++) {
        const unsigned char* rp = U8 + (size_t)__builtin_amdgcn_readlane(nidx, rr) * D + lane * 16;
#pragma unroll
        for (int c = 0; c < 4; c++) ring[rr][c] = *(const u32x4*)(rp + c * 1024);
      }
    }
    float y[16];
#pragma unroll
    for (int i = 0; i < 8; i++) { y[2 * i] = y2[i][0]; y[2 * i + 1] = y2[i][1]; }
    float x2[16];
    float s2 = 0.f;
#pragma unroll
    for (int q = 0; q < 4; q++) {
      f32x4 a = *(const f32x4*)(xs + cbase + 4 * q);
      x2[4 * q] = a[0] + y[4 * q]; x2[4 * q + 1] = a[1] + y[4 * q + 1]; x2[4 * q + 2] = a[2] + y[4 * q + 2]; x2[4 * q + 3] = a[3] + y[4 * q + 3];
    }
#pragma unroll
    for (int i = 0; i < 16; i++) s2 += x2[i] * x2[i];
    s2 = wave_sum(s2);
    if (lane == 0) s_red[wave] = s2;
    __syncthreads();
    const float r3 = rsqrtf((s_red[0] + s_red[1] + s_red[2] + s_red[3]) * (1.0f / D) + EPS);
#pragma unroll
    for (int q = 0; q < 4; q++) {
      f32x4 ga = *(const f32x4*)(gf + cbase + 4 * q);
      f32x4 oa = {x2[4 * q] * r3 * ga[0], x2[4 * q + 1] * r3 * ga[1], x2[4 * q + 2] * r3 * ga[2], x2[4 * q + 3] * r3 * ga[3]};
      *(f32x4*)(xrow + cbase + 4 * q) = oa;
    }
    if (has_next) {
#pragma unroll
      for (int q = 0; q < 4; q++) xr[q] = nxr[q];
    }
    myidx = nidx; tv = ntv;
  }
}

constexpr int NPHASE = 9;

__global__ void __launch_bounds__(512, 2) fwd_mega(Params p) {
  __shared__ __attribute__((aligned(16))) char lds[LDS_BYTES];
  cg::grid_group grid = cg::this_grid();
#ifndef PROBE_MASK
#define PROBE_MASK 0
#endif
#define RUN_PHASE(n, fn) if (p.ph_lo <= n && n < p.ph_hi) { fn(p, lds, 0); if (PROBE_MASK & (1 << n)) { grid.sync(); fn(p, lds, 1); } if (n + 1 < p.ph_hi) grid.sync(); }
  RUN_PHASE(0, phase_prep)
  RUN_PHASE(1, phase_inproj)
  RUN_PHASE(2, phase_elem)
  RUN_PHASE(3, phase_upproj)
  RUN_PHASE(4, phase_attn)
  RUN_PHASE(5, phase_outproj)
  if (p.ph_lo <= 6 && 7 < p.ph_hi) { phase_peerq(p, lds, 0); phase_topk(p, lds, 0); grid.sync(); }
  RUN_PHASE(8, phase_peer)
}

extern "C" void kernel_launch(void* const* d_in, const int* in_sizes, int n_in, void* d_out, int out_size,
                              void* d_ws, size_t ws_size, hipStream_t stream) {
  static int grid_blocks = 0;
  if (!grid_blocks) {
    int dev = 0, cus = 0, per_cu = 0;
    (void)hipGetDevice(&dev);
    (void)hipDeviceGetAttribute(&cus, hipDeviceAttributeMultiprocessorCount, dev);
    (void)hipOccupancyMaxActiveBlocksPerMultiprocessor(&per_cu, fwd_mega, NTHR, 0);
    if (per_cu > 1) per_cu = 1;
    if (per_cu < 1) { fprintf(stderr, "kernel_launch: occupancy query returned %d\n", per_cu); per_cu = 1; }
    grid_blocks = cus * per_cu;
    if (ws_size < WS_END) fprintf(stderr, "kernel_launch: workspace too small: %zu < %zu\n", ws_size, (size_t)WS_END);
    if (n_in != 21) fprintf(stderr, "kernel_launch: expected 21 inputs, got %d\n", n_in);
  }
  Params p{};
  for (int i = 0; i < 21; i++) p.in[i] = (const float*)d_in[i];
  p.out = (float*)d_out;
  p.ws = (unsigned char*)d_ws;
#if N_LAUNCH_PER_PHASE
  for (int ph = 0; ph < NPHASE; ph++) {
    p.ph_lo = ph; p.ph_hi = ph + 1;
    void* args[] = {&p};
    hipError_t e = hipLaunchCooperativeKernel((void*)fwd_mega, dim3(grid_blocks), dim3(NTHR), args, 0, stream);
    if (e != hipSuccess) fprintf(stderr, "cooperative launch failed: %s (grid %d)\n", hipGetErrorString(e), grid_blocks);
  }
#else
  p.ph_lo = 0; p.ph_hi = NPHASE;
  void* args[] = {&p};
  hipError_t e = hipLaunchCooperativeKernel((void*)fwd_mega, dim3(grid_blocks), dim3(NTHR), args, 0, stream);
  if (e != hipSuccess) fprintf(stderr, "cooperative launch failed: %s (grid %d)\n", hipGetErrorString(e), grid_blocks);
#endif
}
```

```cpp
#include <hip/hip_runtime.h>
#include <hip/hip_cooperative_groups.h>
#include <cstdio>
#include <cstdint>
namespace cg = cooperative_groups;

#ifndef N_LAUNCH_PER_PHASE
#define N_LAUNCH_PER_PHASE 0
#endif

#define DI __device__ __forceinline__
typedef unsigned short u16;
typedef __attribute__((ext_vector_type(8))) short bf16x8;
typedef __attribute__((ext_vector_type(4))) short s16x4;
typedef __attribute__((ext_vector_type(16))) float f32x16;
typedef __attribute__((ext_vector_type(4))) float f32x4;
typedef __attribute__((ext_vector_type(4))) unsigned u32x4;
typedef __attribute__((ext_vector_type(2))) unsigned u32x2;
typedef __attribute__((ext_vector_type(2))) float f32x2;
typedef __attribute__((ext_vector_type(2))) __bf16 bf16x2_t;

constexpr int D = 4096;
constexpr int TP = 8192;
constexpr int TS = 1024;
constexpr int T = TP + TS;
constexpr int PAST = 1024;
constexpr int SKV = PAST + 64;
constexpr int KVROWS = TP + 16 * SKV;
constexpr int IN_DIM = 3648;
constexpr int IN_PAD = 3712;
constexpr float EPS = 1e-6f;
constexpr int P4K = 4096 + 128, P1K = 1024 + 128, P512 = 512 + 128, P2K = 2048 + 128, PVT = 8192 + 128;
constexpr float QSCALE = 0.07216878364870322f * 1.4426950408889634f;

constexpr size_t O_Y = 0;
constexpr size_t O_CKVP = 37748736;
constexpr size_t O_KPEP = 41943040;
constexpr size_t O_POOLP = 42467328;
constexpr size_t O_CKVS = 42498048;
constexpr size_t O_KPES = 43022336;
constexpr size_t O_POOLS = 43087872;

constexpr size_t WS_CTL = 0;
constexpr size_t WS_RQ = 4096;
constexpr size_t WS_H = WS_RQ + (size_t)T * 4;
constexpr size_t WS_WIN = WS_H + (size_t)T * P4K * 2;
constexpr size_t WS_WUQ = WS_WIN + (size_t)IN_PAD * P4K * 2;
constexpr size_t WS_WUKV = WS_WUQ + (size_t)3072 * P1K * 2;
constexpr size_t WS_WPOOL = WS_WUKV + (size_t)4096 * P512 * 2;
constexpr size_t WS_WO = WS_WPOOL + (size_t)4 * 512 * P512 * 2;
constexpr size_t WS_WPQ = WS_WO + (size_t)4096 * P4K * 2;
constexpr size_t WS_SK = WS_WPQ + (size_t)2048 * P4K * 2;
constexpr size_t WS_U = (WS_SK + (size_t)2 * 8 * 128 * 128 * 2 + ((size_t)2 << 20) - 1) & ~(((size_t)2 << 20) - 1);
constexpr size_t WS_V = WS_U + (size_t)16384 * 4096;
constexpr size_t WS_USC = WS_V + (size_t)16384 * 4096;
constexpr size_t WS_ZQ = WS_USC + (size_t)2 * 16384 * 4;
constexpr size_t WS_ZKV = WS_ZQ + (size_t)T * P1K * 2;
constexpr size_t WS_ZPOOL = WS_ZKV + (size_t)T * 512 * 4;
constexpr size_t WS_CKVA = WS_ZPOOL + (size_t)T * 2048 * 2;
constexpr size_t WS_KPEA = WS_CKVA + (size_t)KVROWS * P512 * 2;
constexpr size_t WS_DPOOL = WS_KPEA + (size_t)KVROWS * 64 * 2;
constexpr size_t WS_Q = WS_DPOOL + (size_t)T * P2K * 2;
constexpr size_t WS_KN = WS_Q + (size_t)T * 3072 * 2;
constexpr size_t WS_VT = WS_KN + (size_t)KVROWS * P2K * 2;
constexpr size_t WS_O = WS_VT + (size_t)16 * 128 * PVT * 2 + (size_t)16 * 16 * 128 * SKV * 2;
constexpr size_t WS_PQ = WS_O + (size_t)T * P4K * 2;
constexpr size_t WS_IDX = WS_PQ + (size_t)T * P2K * 2;
constexpr size_t WS_TOPV = WS_IDX + (size_t)T * 128 * 4;
constexpr size_t WS_END = WS_TOPV + (size_t)T * 128 * 4;

constexpr int LDS_BYTES = 132096;
constexpr int NTHR = 512, NWAVE = 8;

struct Params {
  const float* in[21];
  float* out;
  unsigned char* ws;
  int ph_lo, ph_hi;
};

DI float bf2f(u16 v) { return __uint_as_float(((unsigned)v) << 16); }
DI float bflo(unsigned v) { return __uint_as_float(v << 16); }
DI float bfhi(unsigned v) { return __uint_as_float(v & 0xffff0000u); }
DI unsigned pack_bf16(float a, float b) {
  f32x2 x = {a, b};
  bf16x2_t y = __builtin_convertvector(x, bf16x2_t);
  return __builtin_bit_cast(unsigned, y);
}
DI u16 f2bf(float a) { return (u16)(pack_bf16(a, 0.f) & 0xffffu); }
DI float wave_sum(float v) {
#pragma unroll
  for (int o = 32; o >= 1; o >>= 1) v += __shfl_xor(v, o);
  return v;
}
DI float dpp_f(float v, int ctrl_quad1, int) { return v; }
DI float wave_sum_dpp(float v) {
  v += __builtin_bit_cast(float, __builtin_amdgcn_update_dpp(0, __builtin_bit_cast(int, v), 0xB1, 0xF, 0xF, false));
  v += __builtin_bit_cast(float, __builtin_amdgcn_update_dpp(0, __builtin_bit_cast(int, v), 0x4E, 0xF, 0xF, false));
  v += __builtin_bit_cast(float, __builtin_amdgcn_update_dpp(0, __builtin_bit_cast(int, v), 0x141, 0xF, 0xF, false));
  v += __builtin_bit_cast(float, __builtin_amdgcn_update_dpp(0, __builtin_bit_cast(int, v), 0x140, 0xF, 0xF, false));
  const int b = __builtin_bit_cast(int, v);
  return __builtin_bit_cast(float, __builtin_amdgcn_readlane(b, 0)) + __builtin_bit_cast(float, __builtin_amdgcn_readlane(b, 16)) +
         __builtin_bit_cast(float, __builtin_amdgcn_readlane(b, 32)) + __builtin_bit_cast(float, __builtin_amdgcn_readlane(b, 48));
}
DI int tok_pos(int t) { return t < TP ? t : PAST + ((t - TP) & 63); }
DI int tok_kvrow(int t) { return t < TP ? t : TP + ((t - TP) >> 6) * SKV + PAST + ((t - TP) & 63); }
DI const float* x_row(const Params& p, int t) { return t < TP ? p.in[0] + (size_t)t * D : p.in[1] + (size_t)(t - TP) * D; }
DI f32x16 mfma32(bf16x8 a, bf16x8 b, f32x16 c) { return __builtin_amdgcn_mfma_f32_32x32x16_bf16(a, b, c, 0, 0, 0); }
DI int crow(int reg, int lh) { return (reg & 3) + 8 * (reg >> 2) + 4 * lh; }
DI float rope_inv(int j) { return powf(10000.0f, -(float)j * (1.0f / 32.0f)); }
DI void rope_sc(int pos, float inv, float& s, float& c) {
  float ang = (float)pos * inv;
  double rev = (double)ang * 0.15915494309189535;
  float fr = (float)(rev - rint(rev));
  s = __builtin_amdgcn_sinf(fr); c = __builtin_amdgcn_cosf(fr);
}

DI void convert_span(const float* __restrict__ src, u16* __restrict__ dst, size_t n) {
  size_t nchunk = n >> 3;
  for (size_t c = (size_t)blockIdx.x * NTHR + threadIdx.x; c < nchunk; c += (size_t)gridDim.x * NTHR) {
    f32x4 a = *(const f32x4*)(src + c * 8), b = *(const f32x4*)(src + c * 8 + 4);
    u32x4 o = {pack_bf16(a[0], a[1]), pack_bf16(a[2], a[3]), pack_bf16(b[0], b[1]), pack_bf16(b[2], b[3])};
    *(u32x4*)(dst + c * 8) = o;
  }
}

DI void transpose_job(const float* __restrict__ src, int K, int N, u16* __restrict__ dst, int ldk,
                      const float* __restrict__ kscale, float* tile_base) {
  const int hb = threadIdx.x >> 8, tid = threadIdx.x & 255;
  float* tile = tile_base + hb * (64 * 65);
  const int ntn = N >> 6, ntiles = (K >> 6) * ntn;
  for (int tb = blockIdx.x * 2; tb < ntiles; tb += gridDim.x * 2) {
    const int ti = tb + hb;
    const bool ok = ti < ntiles;
    const int k0 = (ti / ntn) << 6, n0 = (ti % ntn) << 6;
    __syncthreads();
    if (ok) {
#pragma unroll
      for (int i = 0; i < 4; i++) {
        int kk = (tid >> 4) + 16 * i, nn = (tid & 15) * 4;
        f32x4 v = *(const f32x4*)(src + (size_t)(k0 + kk) * N + n0 + nn);
        float sc = kscale ? kscale[k0 + kk] : 1.0f;
        tile[kk * 65 + nn + 0] = v[0] * sc; tile[kk * 65 + nn + 1] = v[1] * sc;
        tile[kk * 65 + nn + 2] = v[2] * sc; tile[kk * 65 + nn + 3] = v[3] * sc;
      }
    }
    __syncthreads();
    if (ok) {
      const int n = tid >> 2, kc = (tid & 3) * 16;
      unsigned o[8];
#pragma unroll
      for (int j = 0; j < 8; j++) o[j] = pack_bf16(tile[(kc + 2 * j) * 65 + n], tile[(kc + 2 * j + 1) * 65 + n]);
      u16* d = dst + (size_t)(n0 + n) * ldk + k0 + kc;
      *(u32x4*)d = (u32x4){o[0], o[1], o[2], o[3]};
      *(u32x4*)(d + 8) = (u32x4){o[4], o[5], o[6], o[7]};
    }
  }
}

DI void phase_prep(const Params& p, char* lds, int rep) {
  const int lane = threadIdx.x & 63, wave = threadIdx.x >> 6;
  float* fl = (float*)lds;
  unsigned char* ws = p.ws;
  if (blockIdx.x == 0 && threadIdx.x < 256) ((unsigned*)(ws + WS_CTL))[threadIdx.x] = 0u;
  {
    const int hb = threadIdx.x >> 8, tid = threadIdx.x & 255;
    const float* g = p.in[5];
    u16* H = (u16*)(ws + WS_H);
    for (int tb = blockIdx.x * 2; tb < T; tb += gridDim.x * 2) {
      const int t = tb + hb;
      const float* x = x_row(p, t);
      f32x4 v[4]; float ss = 0.f;
#pragma unroll
      for (int i = 0; i < 4; i++) { v[i] = *(const f32x4*)(x + tid * 4 + 1024 * i); ss += v[i][0] * v[i][0] + v[i][1] * v[i][1] + v[i][2] * v[i][2] + v[i][3] * v[i][3]; }
      ss = wave_sum(ss);
      __syncthreads();
      if (lane == 0) fl[wave] = ss;
      __syncthreads();
      float tot = fl[hb * 4 + 0] + fl[hb * 4 + 1] + fl[hb * 4 + 2] + fl[hb * 4 + 3];
      float r = rsqrtf(tot * (1.0f / D) + EPS);
#pragma unroll
      for (int i = 0; i < 4; i++) {
        f32x4 gg = *(const f32x4*)(g + tid * 4 + 1024 * i);
        u32x2 o = {pack_bf16(v[i][0] * r * gg[0], v[i][1] * r * gg[1]), pack_bf16(v[i][2] * r * gg[2], v[i][3] * r * gg[3])};
        *(u32x2*)(H + (size_t)t * P4K + tid * 4 + 1024 * i) = o;
      }
    }
  }
  transpose_job(p.in[6], 4096, IN_DIM, (u16*)(ws + WS_WIN), P4K, nullptr, fl);
  transpose_job(p.in[8], 1024, 3072, (u16*)(ws + WS_WUQ), P1K, p.in[7], fl);
  transpose_job(p.in[10], 512, 4096, (u16*)(ws + WS_WUKV), P512, nullptr, fl);
  for (int g = 0; g < 4; g++)
    transpose_job(p.in[11] + (size_t)g * 512 * 512, 512, 512, (u16*)(ws + WS_WPOOL) + (size_t)g * 512 * P512, P512, nullptr, fl);
  transpose_job(p.in[13], 4096, 4096, (u16*)(ws + WS_WO), P4K, nullptr, fl);
  transpose_job(p.in[15], 4096, 2048, (u16*)(ws + WS_WPQ), P4K, p.in[14], fl);
  convert_span(p.in[16], (u16*)(ws + WS_SK), (size_t)8 * 128 * 128);
  convert_span(p.in[17], (u16*)(ws + WS_SK) + 8 * 128 * 128, (size_t)8 * 128 * 128);
  for (int b = 0; b < 16; b++) {
    {
      const float* src = p.in[2] + (size_t)b * PAST * 512;
      u16* dst = (u16*)(ws + WS_CKVA) + (size_t)(TP + b * SKV) * P512;
      for (int c = blockIdx.x * NTHR + threadIdx.x; c < PAST * 64; c += gridDim.x * NTHR) {
        const int r = c >> 6, cc = (c & 63) * 8;
        f32x4 a = *(const f32x4*)(src + (size_t)r * 512 + cc), bb = *(const f32x4*)(src + (size_t)r * 512 + cc + 4);
        *(u32x4*)(dst + (size_t)r * P512 + cc) = (u32x4){pack_bf16(a[0], a[1]), pack_bf16(a[2], a[3]), pack_bf16(bb[0], bb[1]), pack_bf16(bb[2], bb[3])};
      }
    }
    convert_span(p.in[3] + (size_t)b * PAST * 64, (u16*)(ws + WS_KPEA) + (size_t)(TP + b * SKV) * 64, (size_t)PAST * 64);
  }
  {
    float* isc = (float*)(ws + WS_USC);
    for (int r = blockIdx.x * NWAVE + wave; r < 32768; r += gridDim.x * NWAVE) {
      const float* src = r < 16384 ? p.in[18] + (size_t)r * D : p.in[19] + (size_t)(r - 16384) * D;
      unsigned char* dst = ws + WS_U + (size_t)r * D;
      const bool isu = r < 16384;
      f32x4 v[16];
      float am = 0.f;
#pragma unroll
      for (int c = 0; c < 4; c++)
#pragma unroll
        for (int q = 0; q < 4; q++) {
          f32x4 x = *(const f32x4*)(src + (c * 64 + lane) * 16 + 4 * q);
          if (isu) { f32x4 gg = *(const f32x4*)(p.in[14] + (c * 64 + lane) * 16 + 4 * q); x[0] *= gg[0]; x[1] *= gg[1]; x[2] *= gg[2]; x[3] *= gg[3]; }
          v[c * 4 + q] = x;
          am = fmaxf(am, fmaxf(fmaxf(fabsf(x[0]), fabsf(x[1])), fmaxf(fabsf(x[2]), fabsf(x[3]))));
        }
#pragma unroll
      for (int o = 32; o >= 1; o >>= 1) am = fmaxf(am, __shfl_xor(am, o));
      const float sc = am > 0.f ? exp2f(floorf(log2f(240.0f / am))) : 1.0f;
#pragma unroll
      for (int c = 0; c < 4; c++) {
        u32x4 o;
#pragma unroll
        for (int q = 0; q < 4; q++) {
          f32x4 x = v[c * 4 + q];
          int w = __builtin_amdgcn_cvt_pk_fp8_f32(x[0] * sc, x[1] * sc, 0, false);
          w = __builtin_amdgcn_cvt_pk_fp8_f32(x[2] * sc, x[3] * sc, w, true);
          o[q] = (unsigned)w;
        }
        *(u32x4*)(dst + (c * 64 + lane) * 16) = o;
      }
      if (lane == 0) isc[r] = 1.0f / sc;
    }
  }
}

DI int xcd_tile(int it) {
  const int g = gridDim.x;
  if (g & 7) return it * g + blockIdx.x;
  const int per = g >> 3;
  return (it * 8 + (blockIdx.x & 7)) * per + (blockIdx.x >> 3);
}
DI void blocked_order(int idx, int RM, int NTN, int& mp, int& np) {
  const int sr = idx / (RM * NTN), rem = idx - sr * (RM * NTN);
  np = rem / RM; mp = sr * RM + (rem - np * RM);
}

template <int SM, int SN, int WGM, int WGN, class Epi>
DI void gemm8(const u16* __restrict__ A, int lda, const u16* __restrict__ Bt, int ldb, int K,
              int m0, int n0, bool swap, char* lds, Epi&& epi) {
  static_assert(WGM * WGN == 8, "8 waves");
  constexpr int TM = SM * WGM * 32, TN = SN * WGN * 32, LDK = 72;
  constexpr int CA = TM * 8, CB = TN * 8;
  constexpr int PA = (CA + 511) / 512, PB = (CB + 511) / 512;
  constexpr int STAGE = (TM + TN) * LDK;
  static_assert(2 * STAGE * 2 <= LDS_BYTES, "LDS");
  u16* s0 = (u16*)lds;
  const int tid = threadIdx.x, lane = tid & 63, wave = tid >> 6;
  const int wm = wave / WGN, wn = wave % WGN;
  const int lr = lane & 31, lh = lane >> 5;
  const int srow = tid >> 3, skc = (tid & 7) * 8;
  const u16* ga = A + (size_t)(m0 + srow) * lda + skc;
  const u16* gb = Bt + (size_t)(n0 + srow) * ldb + skc;
  u32x4 ra[PA], rb[PB];
  auto gload = [&](int kt) {
#pragma unroll
    for (int i = 0; i < PA; i++)
      if ((CA % 512 == 0) || (tid + 512 * i < CA)) ra[i] = *(const u32x4*)(ga + (size_t)i * 64 * lda + kt * 64);
#pragma unroll
    for (int i = 0; i < PB; i++)
      if ((CB % 512 == 0) || (tid + 512 * i < CB)) rb[i] = *(const u32x4*)(gb + (size_t)i * 64 * ldb + kt * 64);
  };
  auto gwrite = [&](int b) {
    u16* sA = s0 + b * STAGE;
    u16* sB = sA + TM * LDK;
#pragma unroll
    for (int i = 0; i < PA; i++)
      if ((CA % 512 == 0) || (tid + 512 * i < CA)) *(u32x4*)(sA + (srow + 64 * i) * LDK + skc) = ra[i];
#pragma unroll
    for (int i = 0; i < PB; i++)
      if ((CB % 512 == 0) || (tid + 512 * i < CB)) *(u32x4*)(sB + (srow + 64 * i) * LDK + skc) = rb[i];
  };
  f32x16 acc[SM][SN];
#pragma unroll
  for (int i = 0; i < SM; i++)
#pragma unroll
    for (int j = 0; j < SN; j++)
#pragma unroll
      for (int r = 0; r < 16; r++) acc[i][j][r] = 0.f;
  const int offa = (swap ? TM * LDK + (wn * SN * 32) * LDK : (wm * SM * 32) * LDK) + lr * LDK + lh * 8;
  const int offb = (swap ? (wm * SM * 32) * LDK : TM * LDK + (wn * SN * 32) * LDK) + lr * LDK + lh * 8;
  const int nk = K >> 6;
  __syncthreads();
  gload(0);
  gwrite(0);
  if (nk > 1) gload(1);
  __syncthreads();
  for (int kt = 0; kt < nk; kt++) {
    const int cur = kt & 1;
    if (kt + 1 < nk) gwrite(cur ^ 1);
    if (kt + 2 < nk) gload(kt + 2);
    __builtin_amdgcn_sched_barrier(0);
    const u16* pa = s0 + cur * STAGE + offa;
    const u16* pb = s0 + cur * STAGE + offb;
    bf16x8 af[2][SM], bf[2][SN];
#pragma unroll
    for (int i = 0; i < SM; i++) af[0][i] = *(const bf16x8*)(pa + i * 32 * LDK);
#pragma unroll
    for (int j = 0; j < SN; j++) bf[0][j] = *(const bf16x8*)(pb + j * 32 * LDK);
#pragma unroll
    for (int ks = 0; ks < 4; ks++) {
      if (ks < 3) {
#pragma unroll
        for (int i = 0; i < SM; i++) af[(ks + 1) & 1][i] = *(const bf16x8*)(pa + i * 32 * LDK + (ks + 1) * 16);
#pragma unroll
        for (int j = 0; j < SN; j++) bf[(ks + 1) & 1][j] = *(const bf16x8*)(pb + j * 32 * LDK + (ks + 1) * 16);
      }
#pragma unroll
      for (int i = 0; i < SM; i++)
#pragma unroll
        for (int j = 0; j < SN; j++) acc[i][j] = mfma32(af[ks & 1][i], bf[ks & 1][j], acc[i][j]);
    }
    __syncthreads();
  }
  epi(acc, m0 + wm * SM * 32, n0 + wn * SN * 32, lr, lh);
}

DI void phase_inproj(const Params& p, char* lds, int rep) {
  unsigned char* ws = p.ws;
  const u16* H = (const u16*)(ws + WS_H);
  const u16* W = (const u16*)(ws + WS_WIN);
  u16* ZQ = (u16*)(ws + WS_ZQ);
  float* ZKV = (float*)(ws + WS_ZKV);
  u16* ZPOOL = (u16*)(ws + WS_ZPOOL);
  u16* KPEA = (u16*)(ws + WS_KPEA);
  float* out = p.out;
  constexpr int ntn = IN_DIM / 192, ntiles = (T / 256) * ntn;
  for (int it = 0;; it++) {
    const int ti = xcd_tile(it);
    if (ti >= ntiles) break;
    int mp, np;
    blocked_order(ti, 4, ntn, mp, np);
    const int m0 = mp * 256, n0 = np * 192;
    gemm8<2, 3, 4, 2>(H, P4K, W, P4K, D, m0, n0, false, lds, [&](f32x16 (&acc)[2][3], int rb, int cb, int lr, int lh) {
#pragma unroll
      for (int j = 0; j < 3; j++) {
        const int c0 = cb + 32 * j;
        if (c0 < 1024) {
#pragma unroll
          for (int i = 0; i < 2; i++)
#pragma unroll
            for (int r = 0; r < 16; r++) {
              int row = rb + 32 * i + crow(r, lh);
              ZQ[(size_t)row * P1K + c0 + lr] = f2bf(acc[i][j][r]);
            }
        } else if (c0 < 1536) {
#pragma unroll
          for (int i = 0; i < 2; i++)
#pragma unroll
            for (int r = 0; r < 16; r++) {
              int row = rb + 32 * i + crow(r, lh);
              ZKV[(size_t)row * 512 + c0 - 1024 + lr] = acc[i][j][r];
            }
        } else if (c0 == 1536) {
          if (j + 1 < 3) {
            const float inv = rope_inv(lr);
#pragma unroll
            for (int i = 0; i < 2; i++)
#pragma unroll
              for (int r = 0; r < 16; r++) {
                int row = rb + 32 * i + crow(r, lh);
                float s, c;
                rope_sc(tok_pos(row), inv, s, c);
                float x1 = acc[i][j][r], x2 = acc[i][j + 1 < 3 ? j + 1 : j][r];
                float o1 = x1 * c - x2 * s, o2 = x1 * s + x2 * c;
                float* od = row < TP ? out + O_KPEP + (size_t)row * 64 : out + O_KPES + (size_t)(row - TP) * 64;
                od[lr] = o1; od[32 + lr] = o2;
                u16* kd = KPEA + (size_t)tok_kvrow(row) * 64;
                kd[lr] = f2bf(o1); kd[32 + lr] = f2bf(o2);
              }
          }
        } else if (c0 >= 1600 && c0 < IN_DIM) {
#pragma unroll
          for (int i = 0; i < 2; i++)
#pragma unroll
            for (int r = 0; r < 16; r++) {
              int row = rb + 32 * i + crow(r, lh), col = c0 - 1600 + lr;
              float v = acc[i][j][r];
              ZPOOL[(size_t)row * 2048 + col] = f2bf(v);
              if (row < TP) {
                if (row >= TP - 15) out[O_POOLP + (size_t)(row - (TP - 15)) * 2048 + col] = v;
              } else {
                int tt = (row - TP) & 63, b = (row - TP) >> 6;
                if (tt >= 49) out[O_POOLS + (size_t)(b * 15 + tt - 49) * 2048 + col] = v;
              }
            }
        }
      }
    });
  }
}

DI void phase_elem(const Params& p, char* lds, int rep) {
  unsigned char* ws = p.ws;
  const int tid = threadIdx.x, lane = tid & 63, wave = tid >> 6;
  const u16* ZQ = (const u16*)(ws + WS_ZQ);
  const float* ZKV = (const float*)(ws + WS_ZKV);
  const u16* ZPOOL = (const u16*)(ws + WS_ZPOOL);
  float* RQ = (float*)(ws + WS_RQ);
  u16* CKVA = (u16*)(ws + WS_CKVA);
  u16* DPOOL = (u16*)(ws + WS_DPOOL);
  const float* gkv = p.in[9];
  const float* hist = p.in[4];
  float* out = p.out;
  for (int t = blockIdx.x * NWAVE + wave; t < T; t += gridDim.x * NWAVE) {
    u32x4 zq[2];
    f32x4 zk[2], gk[2];
#pragma unroll
    for (int i = 0; i < 2; i++) {
      zq[i] = *(const u32x4*)(ZQ + (size_t)t * P1K + lane * 8 + 512 * i);
      zk[i] = *(const f32x4*)(ZKV + (size_t)t * 512 + lane * 4 + 256 * i);
      gk[i] = *(const f32x4*)(gkv + lane * 4 + 256 * i);
    }
    u32x4 po[4];
    {
      const bool samp = t >= TP;
      const int tt = samp ? ((t - TP) & 63) : t;
      const int b = samp ? ((t - TP) >> 6) : 0;
      if (tt >= 15) {
#pragma unroll
        for (int g = 0; g < 4; g++) {
          const int w = 2 << g;
          const int ch = g * 512 + lane * 8;
          float s[8], cur[8];
#pragma unroll
          for (int e = 0; e < 8; e++) s[e] = 0.f;
#pragma unroll
          for (int j = 0; j < w; j++) {
            u32x4 v = *(const u32x4*)(ZPOOL + (size_t)(t - j) * 2048 + ch);
#pragma unroll
            for (int e = 0; e < 4; e++) {
              float a = bflo(v[e]), bb = bfhi(v[e]);
              s[2 * e] += a; s[2 * e + 1] += bb;
              if (j == 0) { cur[2 * e] = a; cur[2 * e + 1] = bb; }
            }
          }
          const float ic = 1.0f / (float)w;
          po[g] = (u32x4){pack_bf16(s[0] * ic - cur[0], s[1] * ic - cur[1]), pack_bf16(s[2] * ic - cur[2], s[3] * ic - cur[3]),
                          pack_bf16(s[4] * ic - cur[4], s[5] * ic - cur[5]), pack_bf16(s[6] * ic - cur[6], s[7] * ic - cur[7])};
        }
      } else {
#pragma unroll
        for (int g = 0; g < 4; g++) {
          const int w = 2 << g;
          const int ch = g * 512 + lane * 8;
          float s[8];
#pragma unroll
          for (int e = 0; e < 8; e++) s[e] = 0.f;
          float cur[8];
          int cnt = 0;
          for (int j = 0; j < w; j++) {
            int r = tt - j;
            if (r >= 0) {
              u32x4 v = *(const u32x4*)(ZPOOL + (size_t)(t - j) * 2048 + ch);
#pragma unroll
              for (int e = 0; e < 4; e++) {
                float a = bflo(v[e]), bb = bfhi(v[e]);
                s[2 * e] += a; s[2 * e + 1] += bb;
                if (j == 0) { cur[2 * e] = a; cur[2 * e + 1] = bb; }
              }
              cnt++;
            } else if (samp) {
              const float* hp = hist + ((size_t)b * 15 + (15 + r)) * 2048 + ch;
              f32x4 a = *(const f32x4*)hp, bb = *(const f32x4*)(hp + 4);
              s[0] += a[0]; s[1] += a[1]; s[2] += a[2]; s[3] += a[3];
              s[4] += bb[0]; s[5] += bb[1]; s[6] += bb[2]; s[7] += bb[3];
              cnt++;
            }
          }
          float ic = 1.0f / (float)cnt;
          po[g] = (u32x4){pack_bf16(s[0] * ic - cur[0], s[1] * ic - cur[1]), pack_bf16(s[2] * ic - cur[2], s[3] * ic - cur[3]),
                          pack_bf16(s[4] * ic - cur[4], s[5] * ic - cur[5]), pack_bf16(s[6] * ic - cur[6], s[7] * ic - cur[7])};
        }
      }
    }
    float ssq = 0.f, ssk = 0.f;
#pragma unroll
    for (int i = 0; i < 2; i++) {
#pragma unroll
      for (int e = 0; e < 4; e++) { float a = bflo(zq[i][e]), bq = bfhi(zq[i][e]); ssq += a * a + bq * bq; }
      ssk += zk[i][0] * zk[i][0] + zk[i][1] * zk[i][1] + zk[i][2] * zk[i][2] + zk[i][3] * zk[i][3];
    }
    ssq = wave_sum(ssq);
    ssk = wave_sum(ssk);
    const float rk = rsqrtf(ssk * (1.0f / 512) + EPS);
    if (lane == 0) RQ[t] = rsqrtf(ssq * (1.0f / 1024) + EPS);
    float* od = t < TP ? out + O_CKVP + (size_t)t * 512 : out + O_CKVS + (size_t)(t - TP) * 512;
    u16* cd = CKVA + (size_t)tok_kvrow(t) * P512;
#pragma unroll
    for (int i = 0; i < 2; i++) {
      f32x4 o = {zk[i][0] * rk * gk[i][0], zk[i][1] * rk * gk[i][1], zk[i][2] * rk * gk[i][2], zk[i][3] * rk * gk[i][3]};
      *(f32x4*)(od + lane * 4 + 256 * i) = o;
      *(u32x2*)(cd + lane * 4 + 256 * i) = (u32x2){pack_bf16(o[0], o[1]), pack_bf16(o[2], o[3])};
    }
#pragma unroll
    for (int g = 0; g < 4; g++) *(u32x4*)(DPOOL + (size_t)t * P2K + g * 512 + lane * 8) = po[g];
  }
}

DI void phase_upproj(const Params& p, char* lds, int rep) {
  unsigned char* ws = p.ws;
  constexpr int NT_Q = (T / 256) * 24;
  constexpr int NT_KV = (KVROWS / 256) * 32;
  constexpr int NT_PL = (T / 256) * 16;
  const float* RQ = (const float*)(ws + WS_RQ);
  u16* Q = (u16*)(ws + WS_Q);
  u16* KN = (u16*)(ws + WS_KN);
  u16* VTP = (u16*)(ws + WS_VT);
  u16* VTS = VTP + (size_t)16 * 128 * PVT;
  u16* O = (u16*)(ws + WS_O);
  const float* pscale = p.in[12];
  for (int it = 0;; it++) {
    const int ti = xcd_tile(it);
    if (ti >= NT_Q + NT_KV + NT_PL) break;
    int mp, np;
    if (ti < NT_Q) {
      blocked_order(ti, 4, 24, mp, np);
      const int m0 = mp * 256, n0 = np * 128;
      gemm8<2, 2, 4, 2>((const u16*)(ws + WS_ZQ), P1K, (const u16*)(ws + WS_WUQ), P1K, 1024, m0, n0, false, lds,
                [&](f32x16 (&acc)[2][2], int rb, int cb, int lr, int lh) {
        const bool isrope = (cb % 192) == 128;
        const float inv = rope_inv(lr);
        float rqv[2][16];
#pragma unroll
        for (int i = 0; i < 2; i++)
#pragma unroll
          for (int r = 0; r < 16; r++) rqv[i][r] = RQ[rb + 32 * i + crow(r, lh)];
#pragma unroll
        for (int i = 0; i < 2; i++)
#pragma unroll
          for (int r = 0; r < 16; r++) {
            int row = rb + 32 * i + crow(r, lh);
            float rq = rqv[i][r];
            float x1 = acc[i][0][r] * rq, x2 = acc[i][1][r] * rq;
            if (isrope) {
              float s, c;
              rope_sc(tok_pos(row), inv, s, c);
              float o1 = x1 * c - x2 * s, o2 = x1 * s + x2 * c;
              x1 = o1; x2 = o2;
            }
            Q[(size_t)row * 3072 + cb + lr] = f2bf(x1 * QSCALE);
            Q[(size_t)row * 3072 + cb + 32 + lr] = f2bf(x2 * QSCALE);
          }
      });
    } else if (ti < NT_Q + NT_KV) {
      const int tj = ti - NT_Q;
      blocked_order(tj, 4, 32, mp, np);
      const int m0 = mp * 256, n0 = np * 128;
      const int wn = (threadIdx.x >> 6) & 1;
      const bool swap = ((n0 + wn * 64) & 255) >= 128;
      gemm8<2, 2, 4, 2>((const u16*)(ws + WS_CKVA), P512, (const u16*)(ws + WS_WUKV), P512, 512, m0, n0, swap, lds,
                [&](f32x16 (&acc)[2][2], int rb, int cb, int lr, int lh) {
        const int head = cb >> 8;
        if (!swap) {
#pragma unroll
          for (int i = 0; i < 2; i++)
#pragma unroll
            for (int j = 0; j < 2; j++)
#pragma unroll
              for (int r = 0; r < 16; r++) {
                int row = rb + 32 * i + crow(r, lh), col = (cb & 255) + 32 * j + lr;
                KN[(size_t)row * P2K + head * 128 + col] = f2bf(acc[i][j][r]);
              }
        } else {
#pragma unroll
          for (int i = 0; i < 2; i++)
#pragma unroll
            for (int j = 0; j < 2; j++)
#pragma unroll
              for (int r = 0; r < 16; r++) {
                int vd = (cb & 255) - 128 + 32 * i + crow(r, lh);
                int tok = rb + 32 * j + lr;
                u16* dst;
                if (tok < TP) dst = VTP + ((size_t)(head * 128 + vd)) * PVT + tok;
                else { int rr = tok - TP; int b = rr / SKV, s = rr - b * SKV; dst = VTS + ((size_t)((b * 16 + head) * 128 + vd)) * SKV + s; }
                *dst = f2bf(acc[i][j][r]);
              }
        }
      });
    } else {
      const int tj = ti - NT_KV - NT_Q;
      blocked_order(tj, 4, 16, mp, np);
      const int m0 = mp * 256, g = np >> 2, n0 = (np & 3) * 128;
      gemm8<2, 2, 4, 2>((const u16*)(ws + WS_DPOOL) + g * 512, P2K, (const u16*)(ws + WS_WPOOL) + (size_t)g * 512 * P512, P512, 512, m0, n0, false, lds,
                [&](f32x16 (&acc)[2][2], int rb, int cb, int lr, int lh) {
#pragma unroll
        for (int j = 0; j < 2; j++) {
          int col = g * 512 + cb + 32 * j + lr;
          float sc = pscale[col];
#pragma unroll
          for (int i = 0; i < 2; i++)
#pragma unroll
            for (int r = 0; r < 16; r++) {
              int row = rb + 32 * i + crow(r, lh);
              O[(size_t)row * P4K + 2048 + col] = f2bf(acc[i][j][r] * sc);
            }
        }
      });
    }
  }
}

DI void phase_attn(const Params& p, char* lds, int rep) {
  unsigned char* ws = p.ws;
  const int tid = threadIdx.x, lane = tid & 63, wave = tid >> 6;
  const int lr = lane & 31, lh = lane >> 5;
  const u16* Q = (const u16*)(ws + WS_Q);
  const u16* KN = (const u16*)(ws + WS_KN);
  const u16* KPEA = (const u16*)(ws + WS_KPEA);
  const u16* VTP = (const u16*)(ws + WS_VT);
  const u16* VTS = VTP + (size_t)16 * 128 * PVT;
  u16* O = (u16*)(ws + WS_O);
  const int xq = blockIdx.x & 7;
  unsigned* ctr = (unsigned*)(ws + WS_CTL) + rep * 8 + xq;
  constexpr int KB = 64 * 200, VB = 128 * 68, BUF = KB + VB;
  u16* sbuf = (u16*)lds;
  int* sItem = (int*)(sbuf + 2 * BUF);
  constexpr int NITEM = 64 + 32;
  while (true) {
    __syncthreads();
    if (tid == 0) *sItem = (int)atomicAdd(ctr, 1u);
    __syncthreads();
    const int qi = *sItem;
    if (qi >= NITEM) break;
    const int item = qi < 64 ? ((qi >> 1) << 4) + xq + 8 * (qi & 1) : 512 + (((qi - 64) >> 1) << 4) + xq + 8 * ((qi - 64) & 1);
    int h, q0, kvbase, vstride, ntile, my_ntile;
    bool active;
    const u16* vt;
    if (item < 512) {
      const int qb = 31 - (item >> 4);
      h = item & 15; q0 = qb * 256; kvbase = 0; vt = VTP + (size_t)h * 128 * PVT; vstride = PVT;
      ntile = 4 * qb + 4; my_ntile = 4 * qb + 1 + (wave >> 1); active = true;
    } else {
      const int j = item - 512, b = j >> 4;
      h = j & 15; q0 = TP + b * 64; kvbase = TP + b * SKV; vt = VTS + (size_t)((b * 16 + h) * 128) * SKV; vstride = SKV;
      ntile = 17; my_ntile = 17; active = wave < 2;
    }
    const int qrow = q0 + 32 * (active ? wave : (wave & 1)) + lr;
    bf16x8 qf[12];
    {
      const u16* qp = Q + (size_t)qrow * 3072 + h * 192 + lh * 8;
#pragma unroll
      for (int s = 0; s < 12; s++) qf[s] = *(const bf16x8*)(qp + 16 * s);
    }
    f32x16 ot[4];
#pragma unroll
    for (int d = 0; d < 4; d++)
#pragma unroll
      for (int r = 0; r < 16; r++) ot[d][r] = 0.f;
    float m_run = -INFINITY, l_run = 0.f;
    u32x4 rkn[2], rkp, rvv[2];
    auto stage_load = [&](int kt) {
      const size_t kr0 = (size_t)kvbase + kt * 64;
#pragma unroll
      for (int i = 0; i < 2; i++) {
        int c = tid + 512 * i, key = c >> 4, ch = c & 15;
        rkn[i] = *(const u32x4*)(KN + (kr0 + key) * P2K + h * 128 + ch * 8);
      }
      { int key = tid >> 3, ch = tid & 7; rkp = *(const u32x4*)(KPEA + (kr0 + key) * 64 + ch * 8); }
#pragma unroll
      for (int i = 0; i < 2; i++) {
        int c = tid + 512 * i, vd = c >> 3, ch = c & 7;
        rvv[i] = *(const u32x4*)(vt + (size_t)vd * vstride + kt * 64 + ch * 8);
      }
    };
    auto stage_write = [&](int b) {
      u16* sK = sbuf + b * BUF;
      u16* sV = sK + KB;
#pragma unroll
      for (int i = 0; i < 2; i++) {
        int c = tid + 512 * i, key = c >> 4, ch = c & 15;
        *(u32x4*)(sK + key * 200 + ch * 8) = rkn[i];
      }
      { int key = tid >> 3, ch = tid & 7; *(u32x4*)(sK + key * 200 + 128 + ch * 8) = rkp; }
#pragma unroll
      for (int i = 0; i < 2; i++) {
        int c = tid + 512 * i, vd = c >> 3, ch = c & 7;
        u16* d = sV + vd * 68 + ch * 8;
        *(u32x2*)d = (u32x2){rvv[i][0], rvv[i][1]};
        *(u32x2*)(d + 4) = (u32x2){rvv[i][2], rvv[i][3]};
      }
    };
    stage_load(0);
    stage_write(0);
    if (ntile > 1) stage_load(1);
    __syncthreads();
    for (int kt = 0; kt < ntile; kt++) {
      if (kt + 1 < ntile) stage_write((kt + 1) & 1);
      if (kt + 2 < ntile) stage_load(kt + 2);
      __builtin_amdgcn_sched_barrier(0);
      if (active && kt < my_ntile) {
        const u16* sK = sbuf + (kt & 1) * BUF;
        const u16* sV = sK + KB;
        f32x16 st[2];
#pragma unroll
        for (int t2 = 0; t2 < 2; t2++)
#pragma unroll
          for (int r = 0; r < 16; r++) st[t2][r] = 0.f;
#pragma unroll
        for (int s = 0; s < 12; s++) {
#pragma unroll
          for (int t2 = 0; t2 < 2; t2++) {
            bf16x8 kf = *(const bf16x8*)(sK + (32 * t2 + lr) * 200 + 16 * s + 8 * lh);
            st[t2] = mfma32(kf, qf[s], st[t2]);
          }
        }
        float mx = st[0][0];
#pragma unroll
        for (int t2 = 0; t2 < 2; t2++)
#pragma unroll
          for (int r = 0; r < 16; r++) mx = fmaxf(mx, st[t2][r]);
        mx = fmaxf(mx, __shfl_xor(mx, 32));
        constexpr float THR = 10.0f;
        if (__any(mx - m_run > THR)) {
          const float m_new = fmaxf(m_run, mx);
          const float alpha = __builtin_amdgcn_exp2f(m_run - m_new);
          m_run = m_new;
          l_run *= alpha;
#pragma unroll
          for (int d = 0; d < 4; d++)
#pragma unroll
            for (int r = 0; r < 16; r++) ot[d][r] *= alpha;
        }
        float ps = 0.f;
#pragma unroll
        for (int t2 = 0; t2 < 2; t2++)
#pragma unroll
          for (int r = 0; r < 16; r++) { float e = __builtin_amdgcn_exp2f(st[t2][r] - m_run); st[t2][r] = e; ps += e; }
        l_run += ps;
        bf16x8 pf[2][2];
#pragma unroll
        for (int t2 = 0; t2 < 2; t2++)
#pragma unroll
          for (int s2 = 0; s2 < 2; s2++) {
            u32x4 pk = {pack_bf16(st[t2][8 * s2 + 0], st[t2][8 * s2 + 1]), pack_bf16(st[t2][8 * s2 + 2], st[t2][8 * s2 + 3]),
                        pack_bf16(st[t2][8 * s2 + 4], st[t2][8 * s2 + 5]), pack_bf16(st[t2][8 * s2 + 6], st[t2][8 * s2 + 7])};
            pf[t2][s2] = __builtin_bit_cast(bf16x8, pk);
          }
#pragma unroll
        for (int d = 0; d < 4; d++)
#pragma unroll
          for (int t2 = 0; t2 < 2; t2++)
#pragma unroll
            for (int s2 = 0; s2 < 2; s2++) {
              const u16* vb = sV + (32 * d + lr) * 68 + 32 * t2 + 16 * s2 + 4 * lh;
              u32x2 lo = *(const u32x2*)vb, hi = *(const u32x2*)(vb + 8);
              u32x4 vv = {lo[0], lo[1], hi[0], hi[1]};
              ot[d] = mfma32(__builtin_bit_cast(bf16x8, vv), pf[t2][s2], ot[d]);
            }
      }
      __syncthreads();
    }
    if (active) {
      float lt = l_run + __shfl_xor(l_run, 32);
      float inv = 1.0f / lt;
      u16* od = O + (size_t)qrow * P4K + h * 128 + 4 * lh;
#pragma unroll
      for (int d = 0; d < 4; d++)
#pragma unroll
        for (int g = 0; g < 4; g++) {
          u32x2 o = {pack_bf16(ot[d][4 * g] * inv, ot[d][4 * g + 1] * inv), pack_bf16(ot[d][4 * g + 2] * inv, ot[d][4 * g + 3] * inv)};
          *(u32x2*)(od + 32 * d + 8 * g) = o;
        }
    }
  }
}

DI void phase_outproj(const Params& p, char* lds, int rep) {
  unsigned char* ws = p.ws;
  float* X1 = p.out + O_Y;
  u16* X1B = (u16*)(ws + WS_H);
  constexpr int ntiles = (T / 192) * 16;
  for (int it = 0;; it++) {
    const int ti = xcd_tile(it);
    if (ti >= ntiles) break;
    int mp, np;
    blocked_order(ti, 4, 16, mp, np);
    const int m0 = mp * 192, n0 = np * 256;
    gemm8<3, 2, 2, 4>((const u16*)(ws + WS_O), P4K, (const u16*)(ws + WS_WO), P4K, D, m0, n0, false, lds,
              [&](f32x16 (&acc)[3][2], int rb, int cb, int lr, int lh) {
#pragma unroll
      for (int i = 0; i < 3; i++) {
        float xv[2][16];
#pragma unroll
        for (int j = 0; j < 2; j++)
#pragma unroll
          for (int r = 0; r < 16; r++) xv[j][r] = x_row(p, rb + 32 * i + crow(r, lh))[cb + 32 * j + lr];
#pragma unroll
        for (int j = 0; j < 2; j++)
#pragma unroll
          for (int r = 0; r < 16; r++) {
            int row = rb + 32 * i + crow(r, lh), col = cb + 32 * j + lr;
            float v = xv[j][r] + acc[i][j][r];
            X1[(size_t)row * D + col] = v;
            X1B[(size_t)row * P4K + col] = f2bf(v);
          }
      }
    });
  }
}

DI void wait_cnt(unsigned* c, unsigned need) {
  if (threadIdx.x == 0) {
    while (__hip_atomic_load(c, __ATOMIC_RELAXED, __HIP_MEMORY_SCOPE_AGENT) < need) __builtin_amdgcn_s_sleep(8);
    __threadfence();
  }
  __syncthreads();
}
DI void signal_cnt(unsigned* c) {
  __syncthreads();
  if (threadIdx.x == 0) { __threadfence(); atomicAdd(c, 1u); }
}
constexpr int CW_Q7 = 16, CW_G6M = 64;

DI void phase_peerq(const Params& p, char* lds, int rep) {
  unsigned char* ws = p.ws;
  u16* PQ = (u16*)(ws + WS_PQ);
  constexpr int ntiles = (T / 192) * 8;
  for (int it = 0;; it++) {
    const int ti = xcd_tile(it);
    if (ti >= ntiles) break;
    int mp, np;
    blocked_order(ti, 4, 8, mp, np);
    const int m0 = mp * 192, n0 = np * 256;
    gemm8<3, 2, 2, 4>((const u16*)(ws + WS_H), P4K, (const u16*)(ws + WS_WPQ), P4K, D, m0, n0, false, lds,
              [&](f32x16 (&acc)[3][2], int rb, int cb, int lr, int lh) {
#pragma unroll
      for (int i = 0; i < 3; i++)
#pragma unroll
        for (int j = 0; j < 2; j++)
#pragma unroll
          for (int r = 0; r < 16; r++) {
            int row = rb + 32 * i + crow(r, lh), col = cb + 32 * j + lr;
            PQ[(size_t)row * P2K + col] = f2bf(acc[i][j][r]);
          }
    });
    signal_cnt((unsigned*)(ws + WS_CTL) + CW_G6M + mp);
  }
}

DI void topk_insert(float (&L)[16], float pv) {
  if (pv > L[15]) {
#pragma unroll
    for (int i = 15; i >= 1; i--) L[i] = __builtin_amdgcn_fmed3f(pv, L[i - 1], L[i]);
    L[0] = fmaxf(pv, L[0]);
  }
}

DI void phase_topk(const Params& p, char* lds, int rep) {
  unsigned char* ws = p.ws;
  const int tid = threadIdx.x, lane = tid & 63, wave = tid >> 6;
  const int lr = lane & 31, lh = lane >> 5;
  const u16* PQ = (const u16*)(ws + WS_PQ);
  const u16* SK = (const u16*)(ws + WS_SK);
  int* IDX = (int*)(ws + WS_IDX);
  float* TOPV = (float*)(ws + WS_TOPV);
  float* S = (float*)lds;
  const int nitem = (T / 128) * 8;
  unsigned* cw = (unsigned*)(ws + WS_CTL);
  int* sItem = (int*)(lds + LDS_BYTES - 16);
  while (true) {
    __syncthreads();
    if (tid == 0) *sItem = (int)atomicAdd(cw + CW_Q7, 1u);
    __syncthreads();
    const int it = *sItem;
    if (it >= nitem) break;
    const int t0 = (it >> 3) * 128, h = it & 7;
    {
      const int ma = t0 / 192, mb = (t0 + 127) / 192;
      wait_cnt(cw + CW_G6M + ma, 8);
      if (mb != ma) wait_cnt(cw + CW_G6M + mb, 8);
    }
    const int th = wave >> 2, half = (wave >> 1) & 1, nb = (wave & 1) * 64;
    f32x16 acc[2][2];
#pragma unroll
    for (int i = 0; i < 2; i++)
#pragma unroll
      for (int j = 0; j < 2; j++)
#pragma unroll
        for (int r = 0; r < 16; r++) acc[i][j][r] = 0.f;
    const u16* ap = PQ + (size_t)(t0 + th * 64 + lr) * P2K + h * 256 + half * 128 + lh * 8;
    const u16* bp = SK + ((size_t)(half * 8 + h) * 128 + nb + lr) * 128 + lh * 8;
#pragma unroll
    for (int ks = 0; ks < 8; ks++) {
      bf16x8 a0 = *(const bf16x8*)(ap + ks * 16), a1 = *(const bf16x8*)(ap + (size_t)32 * P2K + ks * 16);
      bf16x8 b0 = *(const bf16x8*)(bp + ks * 16), b1 = *(const bf16x8*)(bp + 32 * 128 + ks * 16);
      acc[0][0] = mfma32(a0, b0, acc[0][0]);
      acc[0][1] = mfma32(a0, b1, acc[0][1]);
      acc[1][0] = mfma32(a1, b0, acc[1][0]);
      acc[1][1] = mfma32(a1, b1, acc[1][1]);
    }
    __syncthreads();
#pragma unroll
    for (int i = 0; i < 2; i++)
#pragma unroll
      for (int j = 0; j < 2; j++)
#pragma unroll
        for (int r = 0; r < 16; r++) {
          int row = th * 64 + 32 * i + crow(r, lh), col = half * 128 + nb + 32 * j + lr;
          S[row * 257 + col] = acc[i][j][r];
        }
    __syncthreads();
    if (tid < 256) {
      const int tok = tid & 127, hf = tid >> 7;
      float* sp = S + tok * 257 + hf * 128;
      float L[16];
#pragma unroll
      for (int i = 0; i < 16; i++) L[i] = -INFINITY;
      for (int j = 0; j < 128; j++) {
        float pv = __uint_as_float((__float_as_uint(sp[j]) & 0xFFFFFF80u) | (unsigned)j);
        topk_insert(L, pv);
      }
#pragma unroll
      for (int i = 0; i < 16; i++) sp[i] = L[i];
    }
    __syncthreads();
    if (tid < 128) {
      const int tok = tid;
      const float* s1 = S + tok * 257;
      const float* s2 = s1 + 128;
      float v1[16], v2[16];
#pragma unroll
      for (int i = 0; i < 16; i++) { v1[i] = s1[i]; v2[i] = s2[i]; }
      float L[16];
#pragma unroll
      for (int i = 0; i < 16; i++) L[i] = -INFINITY;
#pragma unroll
      for (int a = 0; a < 16; a++)
#pragma unroll
        for (int b = 0; b < 16; b++)
          if ((a + 1) * (b + 1) <= 16) {
            float c = v1[a] + v2[b];
            float pv = __uint_as_float((__float_as_uint(c) & 0xFFFFFF00u) | (unsigned)(a * 16 + b));
            topk_insert(L, pv);
          }
      const size_t ob = (size_t)(t0 + tok) * 128 + h * 16;
#pragma unroll
      for (int i = 0; i < 16; i++) {
        unsigned bits = __float_as_uint(L[i]);
        int a = (bits >> 4) & 15, b = bits & 15;
        int i1 = __float_as_uint(s1[a]) & 127, i2 = __float_as_uint(s2[b]) & 127;
        IDX[ob + i] = i1 * 128 + i2;
        TOPV[ob + i] = __uint_as_float(bits & 0xFFFFFF00u);
      }
    }
    __syncthreads();
  }
}

DI f32x2 dot16_fp8(u32x4 w, const float* hv, f32x2 s) {
#pragma unroll
  for (int q = 0; q < 4; q++) {
    f32x2 lo = __builtin_amdgcn_cvt_pk_f32_fp8((int)w[q], false), hi = __builtin_amdgcn_cvt_pk_f32_fp8((int)w[q], true);
    f32x2 h0 = {hv[4 * q], hv[4 * q + 1]}, h1 = {hv[4 * q + 2], hv[4 * q + 3]};
    s = __builtin_elementwise_fma(lo, h0, s);
    s = __builtin_elementwise_fma(hi, h1, s);
  }
  return s;
}

DI void phase_peer(const Params& p, char* lds, int rep) {
  unsigned char* ws = p.ws;
  const int tid = threadIdx.x, lane = tid & 63, wave = (tid >> 6) & 3, hb = tid >> 8;
  const unsigned char* U8 = ws + WS_U;
  const unsigned char* V8 = ws + WS_V;
  const float* USC = (const float*)(ws + WS_USC);
  const float* VSC = USC + 16384;
  const int* IDX = (const int*)(ws + WS_IDX);
  const float* TOPV = (const float*)(ws + WS_TOPV);
  const float* g2 = p.in[14];
  const float* gf = p.in[20];
  float* s_act = (float*)lds + hb * 320;
  int* s_idx = (int*)(s_act + 128);
  float* s_red = (float*)(s_idx + 128);
  float* xs = (float*)lds + 1024 + hb * D;
  const int cbase = wave * 1024 + lane * 16;
  const int k = wave * 32 + (lane & 31);
  const int tl = tid & 255;
  const int tstride = gridDim.x * 2;
  constexpr int NB = 4;
  u32x4 ring[NB][4];
  f32x4 xr[4];
  int myidx = 0;
  float tv = 0.f;
  int t = blockIdx.x * 2 + hb;
  if (t < T) {
    const float* xrow0 = p.out + O_Y + (size_t)t * D;
#pragma unroll
    for (int q = 0; q < 4; q++) xr[q] = *(const f32x4*)(xrow0 + tl * 4 + 1024 * q);
    myidx = IDX[(size_t)t * 128 + k];
    tv = TOPV[(size_t)t * 128 + k];
#pragma unroll
    for (int rr = 0; rr < 2; rr++) {
      const unsigned char* rp = U8 + (size_t)__builtin_amdgcn_readlane(myidx, rr) * D + lane * 16;
#pragma unroll
      for (int c = 0; c < 4; c++) ring[rr][c] = *(const u32x4*)(rp + c * 1024);
    }
  }
  for (; t < T; t += tstride) {
    float* xrow = p.out + O_Y + (size_t)t * D;
    const float usc = USC[myidx], vsc = VSC[myidx];
    {
      const unsigned char* rp = U8 + (size_t)__builtin_amdgcn_readlane(myidx, 2) * D + lane * 16;
#pragma unroll
      for (int c = 0; c < 4; c++) ring[2][c] = *(const u32x4*)(rp + c * 1024);
    }
    if (lane < 32) s_idx[k] = myidx;
    {
      __syncthreads();
#pragma unroll
      for (int q = 0; q < 4; q++) *(f32x4*)(xs + tl * 4 + 1024 * q) = xr[q];
      __syncthreads();
    }
    float hv[64];
    float ss = 0.f;
#pragma unroll
    for (int c = 0; c < 4; c++)
#pragma unroll
      for (int q = 0; q < 4; q++) {
        f32x4 a = *(const f32x4*)(xs + (c * 64 + lane) * 16 + 4 * q);
        hv[c * 16 + q * 4 + 0] = a[0]; hv[c * 16 + q * 4 + 1] = a[1]; hv[c * 16 + q * 4 + 2] = a[2]; hv[c * 16 + q * 4 + 3] = a[3];
      }
#pragma unroll
    for (int i = 0; i < 64; i++) ss += hv[i] * hv[i];
    ss = wave_sum(ss);
    const float r2 = rsqrtf(ss * (1.0f / D) + EPS);
    float z = tv * r2;
    float m = z;
#pragma unroll
    for (int o = 8; o >= 1; o >>= 1) m = fmaxf(m, __shfl_xor(m, o));
    float e = __expf(z - m);
    float se = e;
#pragma unroll
    for (int o = 8; o >= 1; o >>= 1) se += __shfl_xor(se, o);
    const float gate = e / se;
    float a_mine = 0.f;
    for (int j = 0; j < 32; j += NB) {
#pragma unroll
      for (int i = 0; i < NB; i++) {
        const int r = j + i;
        if (r + NB - 1 < 32) {
          const unsigned char* rp = U8 + (size_t)__builtin_amdgcn_readlane(myidx, r + NB - 1) * D + lane * 16;
#pragma unroll
          for (int c = 0; c < 4; c++) ring[(i + NB - 1) % NB][c] = *(const u32x4*)(rp + c * 1024);
        }
        f32x2 sp = {0.f, 0.f};
#pragma unroll
        for (int c = 0; c < 4; c++) sp = dot16_fp8(ring[i][c], &hv[c * 16], sp);
        float s0 = wave_sum_dpp(sp[0] + sp[1]);
        if ((lane & 31) == r) a_mine = s0;
      }
    }
    a_mine *= usc * r2;
    const float act = 0.5f * a_mine * (1.0f + erff(a_mine * 0.7071067811865476f)) * gate * vsc;
    constexpr int VPRE = 8;
    u32x4 vpre[VPRE];
#pragma unroll
    for (int kk = 0; kk < VPRE; kk++) vpre[kk] = *(const u32x4*)(V8 + (size_t)s_idx[kk] * D + cbase);
    if (lane < 32) s_act[k] = act;
    __syncthreads();
    const int tn = t + tstride;
    const bool has_next = tn < T;
    f32x4 nxr[4];
    int nidx = 0;
    float ntv = 0.f;
    if (has_next) {
      const float* xrown = p.out + O_Y + (size_t)tn * D;
#pragma unroll
      for (int q = 0; q < 4; q++) nxr[q] = *(const f32x4*)(xrown + tl * 4 + 1024 * q);
      nidx = IDX[(size_t)tn * 128 + k];
      ntv = TOPV[(size_t)tn * 128 + k];
    }
    f32x2 y2[8];
#pragma unroll
    for (int i = 0; i < 8; i++) y2[i] = (f32x2){0.f, 0.f};
    u32x4 vb1[VPRE];
    auto vload = [&](u32x4 (&dst)[VPRE], int g) __attribute__((always_inline)) {
#pragma unroll
      for (int kk = 0; kk < VPRE; kk++) dst[kk] = *(const u32x4*)(V8 + (size_t)s_idx[g * VPRE + kk] * D + cbase);
    };
    auto vuse = [&](const u32x4 (&src)[VPRE], int g) __attribute__((always_inline)) {
#pragma unroll
      for (int kk = 0; kk < VPRE; kk++) {
        const float av = s_act[g * VPRE + kk];
        const f32x2 av2 = {av, av};
        const u32x4 w = src[kk];
#pragma unroll
        for (int q = 0; q < 4; q++) {
          f32x2 lo = __builtin_amdgcn_cvt_pk_f32_fp8((int)w[q], false), hi = __builtin_amdgcn_cvt_pk_f32_fp8((int)w[q], true);
          y2[2 * q] = __builtin_elementwise_fma(av2, lo, y2[2 * q]);
          y2[2 * q + 1] = __builtin_elementwise_fma(av2, hi, y2[2 * q + 1]);
        }
      }
    };
    vload(vb1, 1);
#pragma unroll 1
    for (int g = 0; g < 128 / VPRE - 2; g += 2) {
      vuse(vpre, g);
      vload(vpre, g + 2);
      vuse(vb1, g + 1);
      vload(vb1, g + 3);
    }
    if (has_next) {
#pragma unroll
      for (int rr = 0; rr < 2; rr++) {
        const unsigned char* rp = U8 + (size_t)__builtin_amdgcn_readlane(nidx, rr) * D + lane * 16;
#pragma unroll
        for (int c = 0; c < 4; c++) ring[rr][c] = *(const u32x4*)(rp + c * 1024);
      }
    }
    vuse(vpre, 128 / VPRE - 2);
    vuse(vb1, 128 / VPRE - 1);
    float y[16];
#pragma unroll
    for (int i = 0; i < 8; i++) { y[2 * i] = y2[i][0]; y[2 * i + 1] = y2[i][1]; }
    float x2[16];
    float s2 = 0.f;
#pragma unroll
    for (int q = 0; q < 4; q++) {
      f32x4 a = *(const f32x4*)(xs + cbase + 4 * q);
      x2[4 * q] = a[0] + y[4 * q]; x2[4 * q + 1] = a[1] + y[4 * q + 1]; x2[4 * q + 2] = a[2] + y[4 * q + 2]; x2[4 * q + 3] = a[3] + y[4 * q + 3];
    }
#pragma unroll
    for (int i = 0; i < 16; i++) s2 += x2[i] * x2[i];
    s2 = wave_sum(s2);
    if (lane == 0) s_red[wave] = s2;
    __syncthreads();
    const float r3 = rsqrtf((s_red[0] + s_red[1] + s_red[2] + s_red[3]) * (1.0f / D) + EPS);
#pragma unroll
    for (int q = 0; q < 4; q++) {
      f32x4 ga = *(const f32x4*)(gf + cbase + 4 * q);
      f32x4 oa = {x2[4 * q] * r3 * ga[0], x2[4 * q + 1] * r3 * ga[1], x2[4 * q + 2] * r3 * ga[2], x2[4 * q + 3] * r3 * ga[3]};
      *(f32x4*)(xrow + cbase + 4 * q) = oa;
    }
    if (has_next) {
#pragma unroll
      for (int q = 0; q < 4; q++) xr[q] = nxr[q];
    }
    myidx = nidx; tv = ntv;
  }
}

constexpr int NPHASE = 9;

__global__ void __launch_bounds__(512, 2) fwd_mega(Params p) {
  __shared__ __attribute__((aligned(16))) char lds[LDS_BYTES];
  cg::grid_group grid = cg::this_grid();
#ifndef PROBE_MASK
#define PROBE_MASK 0
#endif
#define RUN_PHASE(n, fn) if (p.ph_lo <= n && n < p.ph_hi) { fn(p, lds, 0); if (PROBE_MASK & (1 << n)) { grid.sync(); fn(p, lds, 1); } if (n + 1 < p.ph_hi) grid.sync(); }
  RUN_PHASE(0, phase_prep)
  RUN_PHASE(1, phase_inproj)
  RUN_PHASE(2, phase_elem)
  RUN_PHASE(3, phase_upproj)
  RUN_PHASE(4, phase_attn)
  RUN_PHASE(5, phase_outproj)
  if (p.ph_lo <= 6 && 7 < p.ph_hi) { phase_peerq(p, lds, 0); phase_topk(p, lds, 0); grid.sync(); }
  RUN_PHASE(8, phase_peer)
}

extern "C" void kernel_launch(void* const* d_in, const int* in_sizes, int n_in, void* d_out, int out_size,
                              void* d_ws, size_t ws_size, hipStream_t stream) {
  static int grid_blocks = 0;
  if (!grid_blocks) {
    int dev = 0, cus = 0, per_cu = 0;
    (void)hipGetDevice(&dev);
    (void)hipDeviceGetAttribute(&cus, hipDeviceAttributeMultiprocessorCount, dev);
    (void)hipOccupancyMaxActiveBlocksPerMultiprocessor(&per_cu, fwd_mega, NTHR, 0);
    if (per_cu > 1) per_cu = 1;
    if (per_cu < 1) { fprintf(stderr, "kernel_launch: occupancy query returned %d\n", per_cu); per_cu = 1; }
    grid_blocks = cus * per_cu;
    if (ws_size < WS_END) fprintf(stderr, "kernel_launch: workspace too small: %zu < %zu\n", ws_size, (size_t)WS_END);
    if (n_in != 21) fprintf(stderr, "kernel_launch: expected 21 inputs, got %d\n", n_in);
  }
  Params p{};
  for (int i = 0; i < 21; i++) p.in[i] = (const float*)d_in[i];
  p.out = (float*)d_out;
  p.ws = (unsigned char*)d_ws;
#if N_LAUNCH_PER_PHASE
  for (int ph = 0; ph < NPHASE; ph++) {
    p.ph_lo = ph; p.ph_hi = ph + 1;
    void* args[] = {&p};
    hipError_t e = hipLaunchCooperativeKernel((void*)fwd_mega, dim3(grid_blocks), dim3(NTHR), args, 0, stream);
    if (e != hipSuccess) fprintf(stderr, "cooperative launch failed: %s (grid %d)\n", hipGetErrorString(e), grid_blocks);
  }
#else
  p.ph_lo = 0; p.ph_hi = NPHASE;
  void* args[] = {&p};
  hipError_t e = hipLaunchCooperativeKernel((void*)fwd_mega, dim3(grid_blocks), dim3(NTHR), args, 0, stream);
  if (e != hipSuccess) fprintf(stderr, "cooperative launch failed: %s (grid %d)\n", hipGetErrorString(e), grid_blocks);
#endif
}
```
